# Optimizing an MI355X kernel written in HIP

```python
import math
import jax
import jax.numpy as jnp
from jax import lax
import numpy as np

D_MODEL = 2048
BATCH = 2
SEQ = 16384
DEPTH = 1

CTX_LEN = 256
GRID_W = 64
EPS = 1e-6
F32 = jnp.float32

S5_WIDTH = D_MODEL // 2
S5_GROUP = 16
S5_GROUPS = S5_WIDTH // S5_GROUP
S5_STATE = 64
SCAN_CHUNK = 128

LRU_WIDTH = D_MODEL // 2
LRU_HEADS = 16
LRU_BLOCK = LRU_WIDTH // LRU_HEADS
LRU_C = 8.0
CONV_W = 4
CONV_PAD_LO = (CONV_W - 1) // 2
CONV_PAD_HI = CONV_W - 1 - CONV_PAD_LO

N_KEYS = 128
N_EXPERTS = N_KEYS * N_KEYS
PEER_HEADS = 8
PEER_TOPK = 16
PEER_DKEY = 256
PEER_HALF = PEER_DKEY // 2
TOKEN_BLOCK = 128

IN_WIDTH = S5_WIDTH + 2 * LRU_WIDTH + 2 * D_MODEL

kernel_name = 'hybrid_s5_rglru_peer_dit'


def rmsnorm(t, g):
    tf = t.astype(F32)
    y = tf * lax.rsqrt(jnp.mean(tf * tf, axis=-1, keepdims=True) + EPS)
    return (y * g.astype(F32)).astype(t.dtype)


def modulate(t, shift, scale):
    return t * (1 + scale) + shift


def flip_seq(t, rev):
    return jnp.flip(t, axis=1) if rev else t


def linear_combine(e1, e2):
    a1, b1 = e1
    a2, b2 = e2
    return a1 * a2, a2 * b1 + b2


def to_colmajor(t, rows):
    bsz, _, w = t.shape
    return t.reshape(bsz, rows, GRID_W, w).transpose(0, 2, 1, 3)


def from_colmajor(t):
    bsz, gw, rows, w = t.shape
    return t.transpose(0, 2, 1, 3).reshape(bsz, rows * gw, w)


def dwconv(t, w, b):
    out = lax.conv_general_dilated(t, w[:, None, :], window_strides=(1,),
                                   padding=[(CONV_PAD_LO, CONV_PAD_HI)],
                                   dimension_numbers=('NWC', 'WIO', 'NWC'),
                                   feature_group_count=t.shape[-1])
    return out + b


def s5_scan(u, h0, a_bar, b_bar, c_mat, with_output):
    bsz, length = u.shape[0], u.shape[1]
    n_chunks = length // SCAN_CHUNK
    u_chunks = u.reshape(bsz, n_chunks, SCAN_CHUNK, S5_GROUPS, S5_GROUP).swapaxes(0, 1)
    a_seq = jnp.broadcast_to(a_bar, (bsz, SCAN_CHUNK, S5_GROUPS, S5_STATE))

    def step(h, u_blk):
        bu = jnp.einsum('btgh,gph->btgp', u_blk.astype(jnp.complex64), b_bar)
        bu = bu.at[:, 0].add(a_bar * h)
        _, hs = lax.associative_scan(linear_combine, (a_seq, bu), axis=1)
        y = jnp.einsum('btgp,ghp->btgh', hs, c_mat).real if with_output else None
        return hs[:, -1], y

    h_last, y = lax.scan(step, h0, u_chunks)
    if with_output:
        y = y.swapaxes(0, 1).reshape(bsz, length, S5_GROUPS, S5_GROUP)
    return y, h_last


def s5_mixer(u_lat, u_ctx, need_ctx, a_re, a_im, log_dt, b_re, b_im, c_re, c_im, d_skip, w_glu):
    dtype = u_lat.dtype
    bsz = u_lat.shape[0]
    ul = u_lat.astype(F32).reshape(bsz, -1, S5_GROUPS, S5_GROUP)
    uc = u_ctx.astype(F32).reshape(bsz, -1, S5_GROUPS, S5_GROUP)
    d_g = d_skip.astype(F32).reshape(S5_GROUPS, S5_GROUP)
    y_lat = d_g * ul
    y_ctx = d_g * uc if need_ctx else None
    for d in range(2):
        rev = d == 1
        lam = lax.complex(a_re[d].astype(F32), a_im[d].astype(F32))
        dt = jnp.exp(log_dt[d].astype(F32))[:, None]
        a_bar = jnp.exp(lam * dt)
        b_bar = ((a_bar - 1.0) / lam)[..., None] * lax.complex(b_re[d].astype(F32), b_im[d].astype(F32))
        c_mat = lax.complex(c_re[d].astype(F32), c_im[d].astype(F32))
        h0 = jnp.zeros((bsz, S5_GROUPS, S5_STATE), jnp.complex64)
        yc, hc = s5_scan(flip_seq(uc, rev), h0, a_bar, b_bar, c_mat, need_ctx)
        yl, _ = s5_scan(flip_seq(ul, rev), hc, a_bar, b_bar, c_mat, True)
        y_lat = y_lat + flip_seq(yl, rev)
        if need_ctx:
            y_ctx = y_ctx + flip_seq(yc, rev)

    def glu(y):
        z = jax.nn.gelu(y.reshape(y.shape[0], y.shape[1], S5_WIDTH).astype(dtype))
        return z * jax.nn.sigmoid(z @ w_glu)

    return glu(y_lat), (glu(y_ctx) if need_ctx else None)


def rglru_scan(x, h0, lam, w_r, b_r, w_i, b_i):
    xb = x.reshape(x.shape[0], x.shape[1], LRU_HEADS, LRU_BLOCK)
    r = jax.nn.sigmoid(jnp.einsum('blhi,hij->blhj', xb, w_r.astype(F32)).reshape(x.shape) + b_r.astype(F32))
    i = jax.nn.sigmoid(jnp.einsum('blhi,hij->blhj', xb, w_i.astype(F32)).reshape(x.shape) + b_i.astype(F32))
    log_a = -LRU_C * r * jax.nn.softplus(-lam.astype(F32))
    a = jnp.exp(log_a)
    bx = jnp.sqrt(-jnp.expm1(2.0 * log_a)) * (i * x)
    bx = bx.at[:, 0].add(a[:, 0] * h0)
    _, h = lax.associative_scan(linear_combine, (a, bx), axis=1)
    return h, h[:, -1]


def lru_mixer(v_lat, v_ctx, rows, need_ctx, conv_w, conv_b, lam, w_r, b_r, w_i, b_i):
    dtype = v_lat.dtype
    bsz, length, width = v_lat.shape
    vl = to_colmajor(v_lat, rows).reshape(bsz * GRID_W, rows, width)
    xl = dwconv(vl, conv_w, conv_b).reshape(bsz, length, width).astype(F32)
    xc = dwconv(v_ctx, conv_w, conv_b).astype(F32)
    ys_lat = []
    ys_ctx = []
    for d in range(2):
        rev = d == 1
        h0 = jnp.zeros((bsz, width), F32)
        hc, hc_last = rglru_scan(flip_seq(xc, rev), h0, lam[d], w_r[d], b_r[d], w_i[d], b_i[d])
        hl, _ = rglru_scan(flip_seq(xl, rev), hc_last, lam[d], w_r[d], b_r[d], w_i[d], b_i[d])
        ys_lat.append(flip_seq(hl, rev))
        if need_ctx:
            ys_ctx.append(flip_seq(hc, rev))
    y_lat = from_colmajor((ys_lat[0] + ys_lat[1]).reshape(bsz, GRID_W, rows, width))
    y_ctx = (ys_ctx[0] + ys_ctx[1]).astype(dtype) if need_ctx else None
    return y_lat.astype(dtype), y_ctx


def mixer_block(n_lat, n_ctx, rows, need_ctx, w_in, s5_a_re, s5_a_im, s5_log_dt, s5_b_re, s5_b_im,
                s5_c_re, s5_c_im, s5_d, s5_w_glu, lru_conv_w, lru_conv_b, lru_lambda, lru_w_r, lru_b_r,
                lru_w_i, lru_b_i, w_proj_a, w_proj_b, w_out):
    o_v = S5_WIDTH
    o_g = o_v + LRU_WIDTH
    o_ga = o_g + LRU_WIDTH
    o_gb = o_ga + D_MODEL
    z_lat = n_lat @ w_in
    z_ctx = n_ctx @ (w_in if need_ctx else w_in[:, :o_g])
    ya_lat, ya_ctx = s5_mixer(z_lat[..., :o_v], z_ctx[..., :o_v], need_ctx, s5_a_re, s5_a_im, s5_log_dt,
                              s5_b_re, s5_b_im, s5_c_re, s5_c_im, s5_d, s5_w_glu)
    yb_lat, yb_ctx = lru_mixer(z_lat[..., o_v:o_g], z_ctx[..., o_v:o_g], rows, need_ctx, lru_conv_w,
                               lru_conv_b, lru_lambda, lru_w_r, lru_b_r, lru_w_i, lru_b_i)

    def merge(z, ya, yb):
        yb = yb * jax.nn.gelu(z[..., o_g:o_ga])
        m = jax.nn.sigmoid(z[..., o_ga:o_gb]) * (ya @ w_proj_a) + jax.nn.sigmoid(z[..., o_gb:]) * (yb @ w_proj_b)
        return m @ w_out

    out_lat = merge(z_lat, ya_lat, yb_lat)
    out_ctx = merge(z_ctx, ya_ctx, yb_ctx) if need_ctx else None
    return out_lat, out_ctx


def peer_ffn(t, w_query, sub_keys, expert_u, expert_v):
    shape = t.shape
    tokens = t.reshape(-1, TOKEN_BLOCK, D_MODEL)
    sk = sub_keys.astype(F32)
    kk = PEER_TOPK * PEER_TOPK

    def block(xb):
        q = (xb @ w_query).astype(F32).reshape(TOKEN_BLOCK, PEER_HEADS, 2, PEER_HALF)
        s = jnp.einsum('thsc,snc->thsn', q, sk)
        sv, si = lax.top_k(s, PEER_TOPK)
        cand = (sv[:, :, 0, :, None] + sv[:, :, 1, None, :]).reshape(TOKEN_BLOCK, PEER_HEADS, kk)
        cand_idx = (si[:, :, 0, :, None] * N_KEYS + si[:, :, 1, None, :]).reshape(TOKEN_BLOCK, PEER_HEADS, kk)
        top_s, top_pos = lax.top_k(cand, PEER_TOPK)
        e_idx = jnp.take_along_axis(cand_idx, top_pos, axis=-1)
        g = jax.nn.softmax(top_s, axis=-1)
        u = expert_u[e_idx]
        v = expert_v[e_idx]
        act = jax.nn.gelu(jnp.einsum('td,thkd->thk', xb, u).astype(F32))
        return jnp.einsum('thk,thkd->td', (g * act).astype(t.dtype), v)

    return lax.map(block, tokens).reshape(shape)


def setup_inputs(seed: int = 0) -> dict:
    key = jax.random.key(seed)
    k = jax.random.split(key, 40)

    def nrm(i, shape, scale):
        return jax.random.normal(k[i], shape, F32) * scale

    lam_im = jnp.broadcast_to(math.pi * jnp.arange(S5_STATE, dtype=F32), (DEPTH, 2, S5_GROUPS, S5_STATE))
    a_pow = jax.random.uniform(k[20], (DEPTH, 2, LRU_WIDTH), F32, minval=0.9, maxval=0.999)
    a_base = a_pow ** (1.0 / LRU_C)
    return {
        'x': nrm(0, (BATCH, SEQ, D_MODEL), 1.0),
        'c': nrm(1, (BATCH, D_MODEL), 1.0),
        'ctx': nrm(2, (BATCH, CTX_LEN, D_MODEL), 1.0),
        'c_ctx': nrm(3, (D_MODEL,), 1.0),
        'w_ada': nrm(4, (DEPTH, D_MODEL, 6 * D_MODEL), 0.5 * D_MODEL ** -0.5),
        'b_ada': nrm(5, (DEPTH, 6 * D_MODEL), 0.01),
        'g_norm1': 1.0 + nrm(6, (DEPTH, D_MODEL), 0.02),
        'w_in': nrm(7, (DEPTH, D_MODEL, IN_WIDTH), D_MODEL ** -0.5),
        's5_a_re': -0.5 + nrm(8, (DEPTH, 2, S5_GROUPS, S5_STATE), 0.01),
        's5_a_im': lam_im + nrm(9, (DEPTH, 2, S5_GROUPS, S5_STATE), 0.01),
        's5_log_dt': jax.random.uniform(k[10], (DEPTH, 2, S5_GROUPS), F32, minval=math.log(0.001), maxval=math.log(0.1)),
        's5_b_re': nrm(11, (DEPTH, 2, S5_GROUPS, S5_STATE, S5_GROUP), (2 * S5_GROUP) ** -0.5),
        's5_b_im': nrm(12, (DEPTH, 2, S5_GROUPS, S5_STATE, S5_GROUP), (2 * S5_GROUP) ** -0.5),
        's5_c_re': nrm(13, (DEPTH, 2, S5_GROUPS, S5_GROUP, S5_STATE), (2 * S5_STATE) ** -0.5),
        's5_c_im': nrm(14, (DEPTH, 2, S5_GROUPS, S5_GROUP, S5_STATE), (2 * S5_STATE) ** -0.5),
        's5_d': nrm(15, (DEPTH, S5_WIDTH), 1.0),
        's5_w_glu': nrm(16, (DEPTH, S5_WIDTH, S5_WIDTH), S5_WIDTH ** -0.5),
        'lru_conv_w': nrm(17, (DEPTH, CONV_W, LRU_WIDTH), CONV_W ** -0.5),
        'lru_conv_b': nrm(18, (DEPTH, LRU_WIDTH), 0.01),
        'lru_lambda': jnp.log(a_base) - jnp.log1p(-a_base),
        'lru_w_r': nrm(21, (DEPTH, 2, LRU_HEADS, LRU_BLOCK, LRU_BLOCK), LRU_BLOCK ** -0.5),
        'lru_b_r': nrm(22, (DEPTH, 2, LRU_WIDTH), 0.01),
        'lru_w_i': nrm(23, (DEPTH, 2, LRU_HEADS, LRU_BLOCK, LRU_BLOCK), LRU_BLOCK ** -0.5),
        'lru_b_i': nrm(24, (DEPTH, 2, LRU_WIDTH), 0.01),
        'w_proj_a': nrm(25, (DEPTH, S5_WIDTH, D_MODEL), S5_WIDTH ** -0.5),
        'w_proj_b': nrm(26, (DEPTH, LRU_WIDTH, D_MODEL), LRU_WIDTH ** -0.5),
        'w_out': nrm(27, (DEPTH, D_MODEL, D_MODEL), D_MODEL ** -0.5),
        'g_norm2': 1.0 + nrm(28, (DEPTH, D_MODEL), 0.02),
        'peer_w_query': nrm(29, (DEPTH, D_MODEL, PEER_HEADS * PEER_DKEY), D_MODEL ** -0.5),
        'peer_sub_keys': nrm(30, (DEPTH, 2, N_KEYS, PEER_HALF), PEER_HALF ** -0.5),
        'peer_u': nrm(31, (DEPTH, N_EXPERTS, D_MODEL), D_MODEL ** -0.5),
        'peer_v': nrm(32, (DEPTH, N_EXPERTS, D_MODEL), PEER_HEADS ** -0.5),
        'g_final': 1.0 + nrm(33, (D_MODEL,), 0.02),
    }


def reference(x, c, ctx, c_ctx, w_ada, b_ada, g_norm1, w_in, s5_a_re, s5_a_im, s5_log_dt, s5_b_re,
              s5_b_im, s5_c_re, s5_c_im, s5_d, s5_w_glu, lru_conv_w, lru_conv_b, lru_lambda, lru_w_r,
              lru_b_r, lru_w_i, lru_b_i, w_proj_a, w_proj_b, w_out, g_norm2, peer_w_query, peer_sub_keys,
              peer_u, peer_v, g_final):
    rows = x.shape[1] // GRID_W
    sc_lat = jax.nn.silu(c)
    sc_ctx = jax.nn.silu(c_ctx)
    h_lat = x
    h_ctx = ctx
    for layer in range(DEPTH):
        need_ctx = layer < DEPTH - 1
        mod_l = jnp.split((sc_lat @ w_ada[layer] + b_ada[layer])[:, None, :], 6, axis=-1)
        mod_c = jnp.split((sc_ctx @ w_ada[layer] + b_ada[layer])[None, None, :], 6, axis=-1)

        n_lat = modulate(rmsnorm(h_lat, g_norm1[layer]), mod_l[0], mod_l[1])
        n_ctx = modulate(rmsnorm(h_ctx, g_norm1[layer]), mod_c[0], mod_c[1])
        mix_lat, mix_ctx = mixer_block(
            n_lat, n_ctx, rows, need_ctx, w_in[layer], s5_a_re[layer], s5_a_im[layer], s5_log_dt[layer],
            s5_b_re[layer], s5_b_im[layer], s5_c_re[layer], s5_c_im[layer], s5_d[layer], s5_w_glu[layer],
            lru_conv_w[layer], lru_conv_b[layer], lru_lambda[layer], lru_w_r[layer], lru_b_r[layer],
            lru_w_i[layer], lru_b_i[layer], w_proj_a[layer], w_proj_b[layer], w_out[layer])
        h_lat = h_lat + mod_l[2] * mix_lat

        f_lat = modulate(rmsnorm(h_lat, g_norm2[layer]), mod_l[3], mod_l[4])
        h_lat = h_lat + mod_l[5] * peer_ffn(f_lat, peer_w_query[layer], peer_sub_keys[layer], peer_u[layer], peer_v[layer])

        if need_ctx:
            h_ctx = h_ctx + mod_c[2] * mix_ctx
            f_ctx = modulate(rmsnorm(h_ctx, g_norm2[layer]), mod_c[3], mod_c[4])
            h_ctx = h_ctx + mod_c[5] * peer_ffn(f_ctx, peer_w_query[layer], peer_sub_keys[layer], peer_u[layer], peer_v[layer])
    return rmsnorm(h_lat, g_final)
```

```cpp
#include <hip/hip_runtime.h>
#include <hip/hip_cooperative_groups.h>
#include <cstdio>
#include <cstdint>
namespace cg = cooperative_groups;

#define LAS __attribute__((address_space(3)))
typedef unsigned short bf16;
typedef short bf16x8 __attribute__((ext_vector_type(8)));
typedef float f32x4 __attribute__((ext_vector_type(4)));
typedef float f32x16 __attribute__((ext_vector_type(16)));
typedef unsigned u32x4 __attribute__((ext_vector_type(4)));
typedef unsigned u32x2 __attribute__((ext_vector_type(2)));

constexpr int D = 2048, NB = 2, SEQ = 16384, NTOK = NB * SEQ, CTXL = 256, NCTXT = NB * CTXL;
constexpr int S5W = 1024, LRUW = 1024, INW = 7168;
constexpr int NTHREADS = 512, NWAVES = 8;
constexpr int LDS_BYTES = 147456;
constexpr int TCH = 32;
constexpr int NCHUNK = NTOK / TCH;
constexpr int XK = 768;
constexpr int NQ = 520;
constexpr int KSL = 16;

constexpr size_t MiB = 1ull << 20;
constexpr size_t WS_MODP = 1 * MiB;
constexpr size_t WS_MODF = 6 * MiB;
constexpr size_t WS_WIN = 8 * MiB;
constexpr size_t WS_WIN8 = WS_WIN + (size_t)3072 * 4096;
constexpr size_t WS_NBUF8 = 864 * MiB;
constexpr size_t WS_WGLU = 36 * MiB;
constexpr size_t WS_WPA = 38 * MiB;
constexpr size_t WS_WPB = 42 * MiB;
constexpr size_t WS_WOUT = 46 * MiB;
constexpr size_t WS_WQ = 54 * MiB;
constexpr size_t WS_SKB = 62 * MiB;
constexpr size_t WS_LW = 63 * MiB;
constexpr size_t WS_MFULL = 64 * MiB;
constexpr size_t WS_MS = 112 * MiB;
constexpr size_t WS_PU = 128 * MiB;
constexpr size_t WS_PV = 160 * MiB;
constexpr size_t WS_SU = 192 * MiB;
constexpr size_t WS_SV = 192 * MiB + 65536;
constexpr size_t WS_NBUF = 256 * MiB;
constexpr size_t WS_SBUF = 256 * MiB;
constexpr size_t WS_PL = 320 * MiB;
constexpr size_t WS_LC = 338 * MiB;
constexpr size_t WS_X = 384 * MiB;
constexpr size_t WS_YA = 384 * MiB;
constexpr size_t WS_V = 480 * MiB;
constexpr size_t WS_GG = 544 * MiB;
constexpr size_t WS_SA = 608 * MiB;
constexpr size_t WS_Q = 608 * MiB;
constexpr size_t WS_SB = 736 * MiB;
constexpr size_t WS_MIX = 736 * MiB;
constexpr size_t WS_ZA = 864 * MiB;
constexpr size_t WS_YB = 928 * MiB;
constexpr size_t WS_NCTX = 992 * MiB;
constexpr size_t WS_XC = 994 * MiB;
constexpr size_t WS_VC = 995 * MiB;
constexpr size_t WS_SC = 996 * MiB;
constexpr size_t WS_SELE = 194 * MiB;
constexpr size_t WS_SELG = 210 * MiB;
constexpr size_t WS_SELU = 226 * MiB;
constexpr size_t WS_FQ = 384 * MiB;
constexpr size_t WS_FS = 448 * MiB;
constexpr size_t WS_PD = 480 * MiB;
constexpr size_t WS_CFQ = 864 * MiB;
constexpr size_t WS_CS = 880 * MiB;
constexpr size_t WS_PO = 256 * MiB;
constexpr size_t WS_END = 1024 * MiB;
constexpr int CW_RANK = 4096;
constexpr int CW_TICKET = 8192;

struct Params {
    const float* in[33];
    float* out;
    unsigned char* ws;
};

__device__ __forceinline__ unsigned f2bf(float f) { unsigned u = __float_as_uint(f); return (u + 0x7fffu + ((u >> 16) & 1u)) >> 16; }
__device__ __forceinline__ unsigned pk2(float lo, float hi) { return f2bf(lo) | (f2bf(hi) << 16); }
__device__ __forceinline__ unsigned cvt_pk_bf16(float lo, float hi) { unsigned r; asm volatile("v_cvt_pk_bf16_f32 %0, %1, %2" : "=v"(r) : "v"(lo), "v"(hi)); return r; }
__device__ __forceinline__ float bf_lo(unsigned w) { return __uint_as_float(w << 16); }
__device__ __forceinline__ float bf_hi(unsigned w) { return __uint_as_float(w & 0xffff0000u); }
__device__ __forceinline__ float sigmoid_f(float x) { return __builtin_amdgcn_rcpf(1.f + __expf(-x)); }
__device__ __forceinline__ float gelu_f(float x) { const float u = 1.5957691216057308f * (x + 0.044715f * x * x * x); return x * __builtin_amdgcn_rcpf(1.f + __expf(-u)); }
__device__ __forceinline__ float shx(float v, int o, int lane) { return __int_as_float(__builtin_amdgcn_ds_bpermute((lane ^ o) << 2, __float_as_int(v))); }
__device__ __forceinline__ int shx(int v, int o, int lane) { return __builtin_amdgcn_ds_bpermute((lane ^ o) << 2, v); }
__device__ __forceinline__ float wave_sum(float v, int lane) {
#pragma unroll
    for (int o = 1; o < 64; o <<= 1) v += shx(v, o, lane);
    return v;
}
#define LDS_WAIT() asm volatile("s_waitcnt lgkmcnt(0)" ::: "memory")
__device__ __forceinline__ int lane_id() { int l; asm volatile("v_mbcnt_lo_u32_b32 %0, -1, 0\n\tv_mbcnt_hi_u32_b32 %0, -1, %0" : "=v"(l)); return l; }
__device__ __forceinline__ int opaque_tid(int wave_s) { return wave_s * 64 + lane_id(); }

namespace pg8 {
constexpr int BM = 256, BK = 64, HALF = 128, HTB = HALF * BK * 2, STAGE_BYTES = 8 * HTB, NXCD = 8, WGM = 8;
__device__ __forceinline__ int lds_byte(int r, int c) { const int st = (r >> 4) * 2 + (c >> 5), rr = r & 15, cc = c & 31, ob = rr * 64 + cc * 2; return st * 1024 + (ob ^ (((ob >> 9) & 1) << 5)); }
__device__ __forceinline__ void stage_rc(int b, int& R, int& C) { const int st = b / 1024, sb = b % 1024, swz = sb ^ (((sb >> 9) & 1) << 5); R = (st >> 1) * 16 + swz / 64; C = (st & 1) * 32 + (swz % 64) / 2; }
__device__ __forceinline__ int perm32(int rho) { const int n = rho >> 4, i = rho & 15; return 8 * (i >> 2) + 4 * n + (i & 3); }

struct Unit { const char* A; const char* B; int g, pm, pn, ph; };

struct Sched {
    const char* A; const char* B; size_t gA, gB; int lda, ldb, nM, nN, nG, G, c;
    const char* A2; const char* B2; int pair; int esz;
    __device__ __forceinline__ bool next(int i0, Unit& u) const {
        const int i = pair ? (i0 >> 1) : i0; u.ph = pair ? (i0 & 1) : 0;
        const long L = (long)i * G + c; const int per = nM * nN; if (L >= (long)per * nG) return false;
        const int g = (int)(L / per); int wgid = (int)(L % per); int pm, pn;
        if (nG == 1) {
            const int nwg = per; { const int q = nwg / NXCD, r = nwg % NXCD, xcd = wgid % NXCD, off = wgid / NXCD; wgid = (xcd < r ? xcd * (q + 1) : r * (q + 1) + (xcd - r) * q) + off; }
            const int nig = WGM * nN, gid = wgid / nig, fm = gid * WGM, gsz = (nM - fm) < WGM ? (nM - fm) : WGM;
            pm = fm + ((wgid % nig) % gsz); pn = (wgid % nig) / gsz;
        } else { pm = wgid % nM; pn = wgid / nM; }
        u.g = g; u.pm = pm; u.pn = pn;
        u.A = (u.ph ? A2 : A) + (size_t)g * gA + (size_t)pm * BM * lda * esz; u.B = (u.ph ? B2 : B) + (size_t)g * gB + (size_t)pn * BM * ldb * esz;
        return true;
    }
};

enum EpiMode { EM_IN = 0, EM_ING, EM_S5S, EM_S5Y, EM_GLU, EM_PAB, EM_OUT, EM_Q, EM_PROBE };
struct Epi {
    int mode;
    unsigned char* ws; const float* x; float* out; const float* modf;
    __device__ __forceinline__ void store8(bf16* p, const float (&v)[8]) const {
        u32x4 w; w.x = cvt_pk_bf16(v[0], v[1]); w.y = cvt_pk_bf16(v[2], v[3]); w.z = cvt_pk_bf16(v[4], v[5]); w.w = cvt_pk_bf16(v[6], v[7]);
        *(u32x4*)p = w;
    }
    __device__ __forceinline__ void gate(f32x4 (&acc)[2][2][4][2], const Unit& u, int wr, int wc, int fr, int fq) const {
#pragma unroll
            for (int ai = 0; ai < 2; ++ai)
#pragma unroll
                for (int m = 0; m < 4; ++m) {
                    const int row = u.pm * BM + ai * HALF + wr * 64 + m * 16 + fr, dcol = u.pn * HALF + wc * 32 + 8 * fq;
                    float ra[8], sb[8];
#pragma unroll
                    for (int j = 0; j < 8; ++j) {
                        const float za = acc[ai][0][m][j >> 2][j & 3], zb = fmaxf(acc[ai][1][m][j >> 2][j & 3], -30.f * 64.f);
                        const float ea = __builtin_amdgcn_exp2f(za * (-1.4426950408889634f / 64.f)), eb = __builtin_amdgcn_exp2f(zb * (-1.4426950408889634f / 64.f));
                        sb[j] = __builtin_amdgcn_rcpf(1.f + eb);
                        ra[j] = (1.f + eb) * __builtin_amdgcn_rcpf(1.f + ea);
                    }
                    store8((bf16*)(ws + WS_SA) + (size_t)row * D + dcol, ra);
                    store8((bf16*)(ws + WS_SB) + (size_t)row * D + dcol, sb);
                }
    }
    __device__ __forceinline__ void operator()(f32x4 (&acc)[2][2][4][2], const Unit& u, int wr, int wc, int fr, int fq) const {
        if (mode == EM_GLU || mode == EM_PAB) {
            const int ld = (mode == EM_GLU) ? S5W : D;
            const bf16* g0 = (const bf16*)(ws + (mode == EM_GLU ? WS_ZA : (u.ph == 0 ? WS_SA : WS_SB)));
            u32x4 zq[2][4][2];
#pragma unroll
            for (int ai = 0; ai < 2; ++ai)
#pragma unroll
                for (int m = 0; m < 4; ++m)
#pragma unroll
                    for (int bj = 0; bj < 2; ++bj) {
                        const int row = u.pm * BM + ai * HALF + wr * 64 + m * 16 + fr, col = u.pn * BM + bj * HALF + wc * 32 + 8 * fq;
                        zq[ai][m][bj] = *(const u32x4*)(g0 + (size_t)row * ld + col);
                    }
#pragma unroll
            for (int ai = 0; ai < 2; ++ai) {
#pragma unroll
                for (int m = 0; m < 4; ++m)
#pragma unroll
                    for (int bj = 0; bj < 2; ++bj) {
                        const int row = u.pm * BM + ai * HALF + wr * 64 + m * 16 + fr, col = u.pn * BM + bj * HALF + wc * 32 + 8 * fq;
                        const u32x4 z = zq[ai][m][bj];
                        const float zf[8] = {bf_lo(z.x), bf_hi(z.x), bf_lo(z.y), bf_hi(z.y), bf_lo(z.z), bf_hi(z.z), bf_lo(z.w), bf_hi(z.w)};
                        if (mode == EM_PAB && u.ph == 0) {
#pragma unroll
                            for (int j = 0; j < 4; ++j) { acc[ai][bj][m][0][j] *= zf[j]; acc[ai][bj][m][1][j] *= zf[4 + j]; }
                        } else {
                            float v[8];
#pragma unroll
                            for (int j = 0; j < 4; ++j) { v[j] = acc[ai][bj][m][0][j]; v[4 + j] = acc[ai][bj][m][1][j]; }
                            if (mode == EM_GLU) {
#pragma unroll
                                for (int j = 0; j < 8; ++j) v[j] = zf[j] * sigmoid_f(v[j]);
                                store8((bf16*)(ws + WS_YA) + (size_t)row * S5W + col, v);
                            } else {
#pragma unroll
                                for (int j = 0; j < 8; ++j) v[j] *= zf[j];
                                store8((bf16*)(ws + WS_NBUF) + (size_t)row * D + col, v);
                            }
                        }
                    }
            }
            return;
        }
        if (mode == EM_OUT) {
            const float* m2 = modf + (size_t)((u.pm * BM) >> 14) * 12288 + 2 * D;
            f32x4 gq[2][2];
#pragma unroll
            for (int bj = 0; bj < 2; ++bj) { const int col = u.pn * BM + bj * HALF + wc * 32 + 8 * fq; gq[bj][0] = *(const f32x4*)(m2 + col); gq[bj][1] = *(const f32x4*)(m2 + col + 4); }
            f32x4 xq[4][2][2];
#pragma unroll
            for (int m = 0; m < 4; ++m)
#pragma unroll
                for (int bj = 0; bj < 2; ++bj) {
                    const int row = u.pm * BM + wr * 64 + m * 16 + fr, col = u.pn * BM + bj * HALF + wc * 32 + 8 * fq;
                    xq[m][bj][0] = *(const f32x4*)(x + (size_t)row * D + col); xq[m][bj][1] = *(const f32x4*)(x + (size_t)row * D + col + 4);
                }
#pragma unroll
            for (int ai = 0; ai < 2; ++ai) {
#pragma unroll
                for (int m = 0; m < 4; ++m)
#pragma unroll
                    for (int bj = 0; bj < 2; ++bj) {
                        const int row = u.pm * BM + ai * HALF + wr * 64 + m * 16 + fr, col = u.pn * BM + bj * HALF + wc * 32 + 8 * fq;
                        float v[8];
#pragma unroll
                        for (int j = 0; j < 4; ++j) { v[j] = xq[m][bj][0][j] + gq[bj][0][j] * acc[ai][bj][m][0][j]; v[4 + j] = xq[m][bj][1][j] + gq[bj][1][j] * acc[ai][bj][m][1][j]; }
                        if (ai == 0) { xq[m][bj][0] = *(const f32x4*)(x + (size_t)(row + HALF) * D + col); xq[m][bj][1] = *(const f32x4*)(x + (size_t)(row + HALF) * D + col + 4); }
                        store8((bf16*)(ws + WS_MIX) + (size_t)row * D + col, v);
                    }
            }
            return;
        }
#pragma unroll
        for (int ai = 0; ai < 2; ++ai)
#pragma unroll
            for (int m = 0; m < 4; ++m) {
                const int row = u.pm * BM + ai * HALF + wr * 64 + m * 16 + fr;
#pragma unroll
                for (int bj = 0; bj < 2; ++bj) {
                    const int col = u.pn * BM + bj * HALF + wc * 32 + 8 * fq;
                    float v[8];
#pragma unroll
                    for (int j = 0; j < 4; ++j) { v[j] = acc[ai][bj][m][0][j]; v[4 + j] = acc[ai][bj][m][1][j]; }
                    if (mode == EM_IN) {
                        if (u.pn < 4) {
                            const int g = col >> 4, h0 = col & 15;
                            bf16* p = (bf16*)(ws + WS_X) + ((size_t)(g * NCHUNK + (row >> 5)) * XK + (row & 31) * 16 + h0);
                            store8(p, v);
                        } else if (u.pn < 8) {
                            store8((bf16*)(ws + WS_V) + (size_t)row * LRUW + (col - 1024), v);
                        } else {
#pragma unroll
                            for (int j = 0; j < 8; ++j) v[j] = gelu_f(v[j]);
                            store8((bf16*)(ws + WS_GG) + (size_t)row * LRUW + (col - 2048), v);
                        }
                    } else if (mode == EM_S5S) {
                        float* p = (float*)(ws + WS_SBUF) + ((size_t)(u.g * NCHUNK + row) * 256 + col);
                        *(f32x4*)p = (f32x4){v[0], v[1], v[2], v[3]}; *(f32x4*)(p + 4) = (f32x4){v[4], v[5], v[6], v[7]};
                    } else if (mode == EM_S5Y) {
                        const int tok = row * TCH + (col >> 4), ch = u.g * 16 + (col & 15);
#pragma unroll
                        for (int j = 0; j < 8; ++j) v[j] = gelu_f(v[j]);
                        store8((bf16*)(ws + WS_ZA) + (size_t)tok * S5W + ch, v);
                    } else if (mode == EM_PROBE) {
                        asm volatile("" :: "v"(v[0]), "v"(v[1]), "v"(v[2]), "v"(v[3]), "v"(v[4]), "v"(v[5]), "v"(v[6]), "v"(v[7]));
                    } else {
                        store8((bf16*)(ws + WS_Q) + (size_t)row * D + col, v);
                    }
                }
            }
    }
};

typedef int i32x4g __attribute__((ext_vector_type(4)));
typedef int i32x8g __attribute__((ext_vector_type(8)));
__device__ __forceinline__ i32x8g cat8(const bf16x8& lo, const bf16x8& hi) { return __builtin_shufflevector(__builtin_bit_cast(i32x4g, lo), __builtin_bit_cast(i32x4g, hi), 0, 1, 2, 3, 4, 5, 6, 7); }
template <bool F8 = false>
__device__ __forceinline__ void gemm_phase(LAS unsigned char* lds, const int K, const Sched& S, const Epi& E, const int wave_s) {
    const int tid = opaque_tid(wave_s), wid = wave_s, lane = tid & 63, wr = wid >> 2, wc = wid & 3, fr = lane & 15, fq = lane >> 4;
    const int nt = F8 ? K / (2 * BK) : K / BK, lda = F8 ? S.lda / 2 : S.lda, ldb = F8 ? S.ldb / 2 : S.ldb;
    const bool align = true;
    unsigned voffA[2], voffB[2];
#pragma unroll
    for (int i = 0; i < 2; ++i) { int R, C; stage_rc(tid * 16 + i * 8192, R, C); const int Rb = (R & ~31) + perm32(R & 31);
        voffA[i] = (unsigned)(R * lda + C) * 2u; voffB[i] = (unsigned)(Rb * ldb + C) * 2u;
        if (E.mode == EM_PROBE) { voffA[i] = voffB[i] = (unsigned)(tid * 16 + i * 8192); } }
    const size_t kstep = (E.mode == EM_PROBE) ? (size_t)32768 : (size_t)(BK * 2);
    const size_t hstepA = (E.mode == EM_PROBE) ? (size_t)16384 : (size_t)HALF * lda * 2, hstepB = (E.mode == EM_PROBE) ? (size_t)16384 : (size_t)HALF * ldb * 2;
    const unsigned ldsw = (unsigned)wid * 1024u;
    const int aoff = lds_byte(wr * 64 + fr, fq * 8), boff = lds_byte(wc * 32 + fr, fq * 8);
#define PG8_SA(b, h) (((b) * 2 + (h)) * HTB)
#define PG8_SB(b, h) ((4 + (b) * 2 + (h)) * HTB)
#define PG8_STAGE(bufoff, gbase, voff) do { _Pragma("unroll") for (int _i = 0; _i < 2; ++_i) { unsigned _vo = (voff)[_i]; asm volatile("" : "+v"(_vo));   \
        __builtin_amdgcn_global_load_lds((const unsigned*)((const char*)(gbase) + _vo), (LAS unsigned*)(lds + (bufoff) + ldsw + _i * 8192), 16, 0, 0); } } while (0)
#define PG8_LDA(dst, b, h) do { _Pragma("unroll") for (int m = 0; m < 4; ++m) _Pragma("unroll") for (int k = 0; k < 2; ++k) dst[m][k] = *(const LAS bf16x8*)(lds + PG8_SA(b, h) + aoff + m * 2048 + k * 1024); } while (0)
#define PG8_LDB(dst, b, h) do { _Pragma("unroll") for (int n = 0; n < 2; ++n) _Pragma("unroll") for (int k = 0; k < 2; ++k) dst[n][k] = *(const LAS bf16x8*)(lds + PG8_SB(b, h) + boff + n * 2048 + k * 1024); } while (0)
#define PG8_MMA(ai, bj, At, Bt) do { __builtin_amdgcn_s_setprio(1); \
        if (F8) { _Pragma("unroll") for (int m = 0; m < 4; ++m) _Pragma("unroll") for (int n = 0; n < 2; ++n) \
            acc[ai][bj][m][n] = __builtin_amdgcn_mfma_scale_f32_16x16x128_f8f6f4(cat8(Bt[n][0], Bt[n][1]), cat8(At[m][0], At[m][1]), acc[ai][bj][m][n], 0, 0, 0, 0, 0, 0); } \
        else { _Pragma("unroll") for (int m = 0; m < 4; ++m) _Pragma("unroll") for (int n = 0; n < 2; ++n) _Pragma("unroll") for (int k = 0; k < 2; ++k) \
            acc[ai][bj][m][n] = __builtin_amdgcn_mfma_f32_16x16x32_bf16(Bt[n][k], At[m][k], acc[ai][bj][m][n], 0, 0, 0); } \
        __builtin_amdgcn_s_setprio(0); } while (0)
#define PG8_WAIT_V(n) asm volatile("s_waitcnt vmcnt(" #n ")" ::: "memory")
#define PG8_WAIT_L(n) asm volatile("s_waitcnt lgkmcnt(" #n ")" ::: "memory")
#define PG8_BAR __builtin_amdgcn_s_barrier()
#define PG8_SCHED __builtin_amdgcn_sched_barrier(0)
    Unit cur, nxt; int ui = 0;
    if (!S.next(0, cur)) return;
    f32x4 acc[2][2][4][2];
#pragma unroll
    for (int a = 0; a < 2; ++a)
#pragma unroll
        for (int b = 0; b < 2; ++b)
#pragma unroll
            for (int m = 0; m < 4; ++m)
#pragma unroll
                for (int n = 0; n < 2; ++n) acc[a][b][m][n] = (f32x4){0.f, 0.f, 0.f, 0.f};
    bf16x8 At[4][2], B0[2][2], B1[2][2];
    const char* cA = cur.A; const char* cB = cur.B;
    PG8_STAGE(PG8_SB(0, 0), cB, voffB); PG8_STAGE(PG8_SB(0, 1), cB + hstepB, voffB); PG8_STAGE(PG8_SA(0, 0), cA, voffA); PG8_STAGE(PG8_SA(0, 1), cA + hstepA, voffA);
    if (wr == 1) PG8_BAR;
    PG8_WAIT_V(2); PG8_BAR;
    PG8_STAGE(PG8_SB(1, 0), cB + kstep, voffB); PG8_STAGE(PG8_SA(1, 0), cA + kstep, voffA); PG8_STAGE(PG8_SB(1, 1), cB + hstepB + kstep, voffB);
    PG8_WAIT_V(6); PG8_BAR;
    for (;;) {
        const bool has_next = S.next(ui + 1, nxt);
        const char* nA = has_next ? nxt.A : cA; const char* nB = has_next ? nxt.B : cB;
        for (int t = 0; t < nt; t += 2) {
            const bool last = (t == nt - 2);
            const char* a1 = cA + (size_t)(t + 1) * kstep;
            const char* a2 = last ? nA : cA + (size_t)(t + 2) * kstep; const char* b2 = last ? nB : cB + (size_t)(t + 2) * kstep;
            const char* a3 = a2 + kstep; const char* b3 = b2 + kstep;
            PG8_LDB(B0, 0, 0); PG8_LDB(B1, 0, 1); PG8_SCHED; PG8_LDA(At, 0, 0); PG8_STAGE(PG8_SA(1, 1), a1 + hstepA, voffA);
            PG8_WAIT_V(8); PG8_WAIT_L(0); PG8_BAR; PG8_MMA(0, 0, At, B0); PG8_MMA(0, 1, At, B1); PG8_BAR; PG8_SCHED;
            PG8_LDA(At, 0, 1); PG8_STAGE(PG8_SB(0, 0), b2, voffB); PG8_STAGE(PG8_SB(0, 1), b2 + hstepB, voffB); PG8_STAGE(PG8_SA(0, 0), a2, voffA);
            PG8_WAIT_V(8); PG8_WAIT_L(0); PG8_BAR; PG8_MMA(1, 0, At, B0); PG8_MMA(1, 1, At, B1); PG8_BAR; PG8_SCHED;
            PG8_LDB(B0, 1, 0); PG8_LDB(B1, 1, 1); PG8_SCHED; PG8_LDA(At, 1, 0); PG8_STAGE(PG8_SA(0, 1), a2 + hstepA, voffA);
            PG8_WAIT_V(8); PG8_WAIT_L(0); PG8_BAR; PG8_MMA(0, 0, At, B0); PG8_MMA(0, 1, At, B1); PG8_BAR; PG8_SCHED;
            PG8_LDA(At, 1, 1); PG8_STAGE(PG8_SB(1, 0), b3, voffB); PG8_STAGE(PG8_SB(1, 1), b3 + hstepB, voffB); PG8_STAGE(PG8_SA(1, 0), a3, voffA);
            PG8_WAIT_V(8); PG8_WAIT_L(0); PG8_BAR; PG8_MMA(1, 0, At, B0); PG8_MMA(1, 1, At, B1); PG8_BAR; PG8_SCHED;
        }
        if (align) { if (wr == 0) PG8_BAR; }
        { const int lx = lane_id(); if (F8) E.gate(acc, cur, wr, wc, lx & 15, lx >> 4); else E(acc, cur, wr, wc, lx & 15, lx >> 4); }
        if (!has_next) break;
        if (!(E.mode == EM_PAB && cur.ph == 0)) {
#pragma unroll
        for (int a = 0; a < 2; ++a)
#pragma unroll
            for (int b = 0; b < 2; ++b)
#pragma unroll
                for (int m = 0; m < 4; ++m)
#pragma unroll
                    for (int n = 0; n < 2; ++n) acc[a][b][m][n] = (f32x4){0.f, 0.f, 0.f, 0.f};
        }
        cur = nxt; cA = nA; cB = nB; ++ui;
        if (align) { if (wr == 1) PG8_BAR; }
    }
    PG8_WAIT_V(0);
    if (!align) { if (wr == 0) PG8_BAR; }
    PG8_BAR;
#undef PG8_SA
#undef PG8_SB
#undef PG8_STAGE
#undef PG8_LDA
#undef PG8_LDB
#undef PG8_MMA
#undef PG8_WAIT_V
#undef PG8_WAIT_L
#undef PG8_BAR
#undef PG8_SCHED
}
}

#define XB_TMO      128
#define XB_XCNT(j)  (256  + 64 * (j))
#define XB_XSUB(j)  (1280 + 64 * (j))
#define XB_XGEN(j)  (2304 + 64 * (j))
#define XB_TOP      3328
#define XB_TOPGEN   3392
#define XCD_BAR_WORDS 3456
#define XB_SPIN_CAP (1u << 18)
__device__ __forceinline__ unsigned xb_ld(unsigned* p)              { return __hip_atomic_load(p, __ATOMIC_RELAXED, __HIP_MEMORY_SCOPE_AGENT); }
__device__ __forceinline__ unsigned xb_add(unsigned* p, unsigned v) { return __hip_atomic_fetch_add(p, v, __ATOMIC_RELAXED, __HIP_MEMORY_SCOPE_AGENT); }
__device__ __forceinline__ unsigned xb_xcc_id() { return (unsigned)__builtin_amdgcn_s_getreg((3 << 11) | 20) & 0xFu; }
#define XB_SPIN(cond, bar) do { unsigned _sp = 0; while (cond) { __builtin_amdgcn_s_sleep(1); \
    if ((++_sp & 255u) == 0u) { if (xb_ld(&(bar)[XB_TMO])) break; if (_sp > XB_SPIN_CAP) { atomicAdd(&(bar)[XB_TMO], 1u); break; } } } } while (0)
struct XcdBarrier { unsigned* bar; unsigned x; volatile LAS unsigned* st; };
__device__ __forceinline__ XcdBarrier xcd_barrier_post(unsigned* bar, volatile LAS unsigned* st, bool lead) {
    XcdBarrier b; b.bar = bar; b.x = xb_xcc_id(); b.st = st;
    if (lead) (void)xb_add(&bar[XB_XCNT(b.x)], 1u);
    return b;
}
__device__ __forceinline__ void xcd_barrier_complete(unsigned* bar, unsigned x, unsigned& nloc, unsigned& nx) {
    const unsigned G = gridDim.x * gridDim.y * gridDim.z;
    unsigned sum, cnt, mine, sp = 0u;
    for (;;) {
        sum = 0u; cnt = 0u; mine = 0u;
#pragma unroll
        for (unsigned j = 0; j < 16; ++j) { const unsigned c = xb_ld(&bar[XB_XCNT(j)]); sum += c; cnt += (c > 0u) ? 1u : 0u; mine = (j == x) ? c : mine; }
        if (sum == G) break;
        __builtin_amdgcn_s_sleep(1);
        if ((++sp & 255u) == 0u) { if (xb_ld(&bar[XB_TMO])) break; if (sp > XB_SPIN_CAP) { atomicAdd(&bar[XB_TMO], 1u); break; } }
    }
    nloc = mine > 0u ? mine : 1u; nx = cnt > 0u ? cnt : 1u;
}
__device__ __forceinline__ void xcd_barrier(const XcdBarrier& b, bool lead) {
    asm volatile("s_waitcnt vmcnt(0)" ::: "memory");
    __syncthreads();
    if (lead) {
        unsigned* bar = b.bar;
        __builtin_amdgcn_s_waitcnt(0);
        unsigned nloc = b.st[0], nx = b.st[1];
        if (nloc == 0u) { xcd_barrier_complete(bar, b.x, nloc, nx); b.st[0] = nloc; b.st[1] = nx; }
        const unsigned old = xb_add(&bar[XB_XSUB(b.x)], 1u);
        const unsigned gen = old / nloc;
        if (old + 1u == (gen + 1u) * nloc) {
            __builtin_amdgcn_fence(__ATOMIC_RELEASE, "agent");
            asm volatile("s_waitcnt vmcnt(0)" ::: "memory");
            const unsigned og = xb_add(&bar[XB_TOP], 1u);
            const unsigned tg = og / nx;
            if (og + 1u == (tg + 1u) * nx) xb_add(&bar[XB_TOPGEN], 1u);
            else XB_SPIN(xb_ld(&bar[XB_TOPGEN]) == tg, bar);
            __builtin_amdgcn_fence(__ATOMIC_ACQUIRE, "agent");
            xb_add(&bar[XB_XGEN(b.x)], 1u);
            asm volatile("s_waitcnt vmcnt(0)" ::: "memory");
        } else {
            XB_SPIN(xb_ld(&bar[XB_XGEN(b.x)]) == gen, bar);
            __builtin_amdgcn_fence(__ATOMIC_ACQUIRE, "agent");
            asm volatile("s_waitcnt vmcnt(0)" ::: "memory");
        }
    }
    __syncthreads();
}

struct Frame {
    LAS unsigned char* lds;
    int tid, lane, wave, G, bx;
    unsigned char* ws;
};

__device__ __forceinline__ void big_gemm(Frame& F, const Params& p, int mode, const void* A, int lda, const void* B, int ldb, int M, int N, int K) {
    pg8::Sched S; S.A = (const char*)A; S.B = (const char*)B; S.gA = 0; S.gB = 0; S.lda = lda; S.ldb = ldb; S.nM = M / 256; S.nN = N / 256; S.nG = 1; S.G = F.G; S.c = F.bx; S.A2 = S.A; S.B2 = S.B; S.pair = 0; S.esz = 2;
    pg8::Epi E; E.mode = mode; E.ws = F.ws; E.x = p.in[0]; E.out = p.out; E.modf = (const float*)(F.ws + WS_MODF);
    pg8::gemm_phase(F.lds, K, S, E, F.wave);
}

__device__ __forceinline__ void p0_transpose_item(const float* W, int K, int N, bf16* WT, LAS float* scr, int item, int lane, bool gatemix = false) {
    const int nblk = N / 32, kb = item / nblk, nb = item % nblk, k0 = 64 * kb, n0 = 32 * nb;
    int nd0 = n0;
    if (gatemix && n0 >= 3072) { const int a = (n0 - 3072) >> 11, d = (n0 - 3072) & 2047; nd0 = 3072 + (d >> 7) * 256 + a * 128 + (d & 127); }
#pragma unroll 8
    for (int i = 0; i < 32; ++i) { const int kk = 2 * i + (lane >> 5); scr[kk * 33 + (lane & 31)] = W[(size_t)(k0 + kk) * N + n0 + (lane & 31)]; }
    LDS_WAIT(); asm volatile("" ::: "memory");
    const int c = lane & 7;
#pragma unroll
    for (int j = 0; j < 4; ++j) { const int n = (lane >> 3) + 8 * j; const LAS float* s = scr + (8 * c) * 33 + n;
        if (gatemix && n0 >= 3072) {
            int w0 = __builtin_amdgcn_cvt_pk_fp8_f32(64.f * s[0 * 33], 64.f * s[1 * 33], 0, false); w0 = __builtin_amdgcn_cvt_pk_fp8_f32(64.f * s[2 * 33], 64.f * s[3 * 33], w0, true);
            int w1 = __builtin_amdgcn_cvt_pk_fp8_f32(64.f * s[4 * 33], 64.f * s[5 * 33], 0, false); w1 = __builtin_amdgcn_cvt_pk_fp8_f32(64.f * s[6 * 33], 64.f * s[7 * 33], w1, true);
            u32x2 o2; o2.x = (unsigned)w0; o2.y = (unsigned)w1;
            *(u32x2*)((unsigned char*)WT + (WS_WIN8 - WS_WIN) + (size_t)(nd0 - 3072 + n) * K + k0 + 8 * c) = o2;
            continue;
        }
        u32x4 o; o.x = pk2(s[0 * 33], s[1 * 33]); o.y = pk2(s[2 * 33], s[3 * 33]); o.z = pk2(s[4 * 33], s[5 * 33]); o.w = pk2(s[6 * 33], s[7 * 33]);
        *(u32x4*)(WT + (size_t)(nd0 + n) * K + k0 + 8 * c) = o; }
    LDS_WAIT(); asm volatile("" ::: "memory");
}

__device__ __forceinline__ void p0_mod_item(Frame& F, const Params& p, int item) {
    constexpr int KS = D / KSL;
    LAS float* sv = (LAS float*)F.lds;
    const int ks = item / 6, cb = item % 6, k0 = ks * KS;
    __syncthreads();
    for (int i = F.tid; i < 3 * KS; i += NTHREADS) { const int r = i / KS, k = i % KS; const float c = (r < 2) ? p.in[1][r * D + k0 + k] : p.in[3][k0 + k]; sv[i] = c / (1.f + __expf(-c)); }
    __syncthreads();
    const int col = cb * 2048 + F.tid * 4;
    const float* W = p.in[4] + (size_t)k0 * 12288 + col;
    f32x4 a0 = {0, 0, 0, 0}, a1 = a0, a2 = a0;
#pragma unroll 16
    for (int k = 0; k < KS; ++k) { const f32x4 w = *(const f32x4*)(W + (size_t)k * 12288); a0 += w * sv[k]; a1 += w * sv[KS + k]; a2 += w * sv[2 * KS + k]; }
    float* o = (float*)(F.ws + WS_MODP) + (size_t)ks * 3 * 12288 + col;
    *(f32x4*)o = a0; *(f32x4*)(o + 12288) = a1; *(f32x4*)(o + 2 * 12288) = a2;
}

__device__ __forceinline__ void p0_s5_tables(Frame& F, const Params& p, int g, int half) {
    typedef float f2 __attribute__((ext_vector_type(2)));
    LAS f2* pw = (LAS f2*)F.lds;
    LAS f2* Bb = (LAS f2*)(F.lds + 34560);
    LAS f2* Cc = (LAS f2*)(F.lds + 34560 + 16384);
    LAS float* Kt = (LAS float*)(F.lds + 34560 + 16384 + 16640);
    const float* a_re = p.in[8]; const float* a_im = p.in[9]; const float* log_dt = p.in[10];
    const float* b_re = p.in[11]; const float* b_im = p.in[12]; const float* c_re = p.in[13]; const float* c_im = p.in[14]; const float* dsk = p.in[15];
    __syncthreads();
    if (F.tid < 128) {
        const int d = F.tid >> 6, pp = F.tid & 63;
        const float lr = a_re[(d * 64 + g) * 64 + pp], li = a_im[(d * 64 + g) * 64 + pp], dt = __expf(log_dt[d * 64 + g]);
        {
            const float mag1 = expf(dt * lr); float sn1, cs1; sincosf(dt * li, &sn1, &cs1); const float ar = mag1 * cs1, ai = mag1 * sn1; float wr = 1.f, wi = 0.f;
            for (int tau = 0; tau <= 32; ++tau) { pw[(d * 33 + tau) * 65 + pp] = (f2){wr, wi}; const float nr = wr * ar - wi * ai; wi = wr * ai + wi * ar; wr = nr; }
        }
        const float x = dt * lr, y = dt * li; float sn, cs, sh, ch; sincosf(y, &sn, &cs); sincosf(0.5f * y, &sh, &ch);
        const float em = expm1f(x), nr = em * cs - 2.f * sh * sh, ni = (em + 1.f) * sn;
        const float den = lr * lr + li * li, qr = (nr * lr + ni * li) / den, qi = (ni * lr - nr * li) / den;
        for (int h = 0; h < 16; ++h) { const float br = b_re[((d * 64 + g) * 64 + pp) * 16 + h], bi = b_im[((d * 64 + g) * 64 + pp) * 16 + h]; Bb[(d * 64 + pp) * 16 + h] = (f2){qr * br - qi * bi, qr * bi + qi * br}; }
        for (int h = 0; h < 16; ++h) Cc[(d * 16 + h) * 65 + pp] = (f2){c_re[((d * 64 + g) * 16 + h) * 64 + pp], c_im[((d * 64 + g) * 16 + h) * 64 + pp]};
    }
    __syncthreads();
    {
        const int d = F.tid >> 8, tau = (F.tid >> 3) & 31, hp0 = (F.tid & 7) * 2;
        for (int hh = 0; hh < 2; ++hh) {
            const int hp = hp0 + hh; float accv[16];
#pragma unroll
            for (int h = 0; h < 16; ++h) accv[h] = 0.f;
            for (int pp = 0; pp < 64; ++pp) {
                const f2 c = Cc[(d * 16 + hp) * 65 + pp], w = pw[(d * 33 + tau) * 65 + pp]; const float wr = c.x * w.x - c.y * w.y, wi = c.x * w.y + c.y * w.x;
#pragma unroll
                for (int h = 0; h < 16; ++h) { const f2 b = Bb[(d * 64 + pp) * 16 + h]; accv[h] += wr * b.x - wi * b.y; }
            }
#pragma unroll
            for (int h = 0; h < 16; ++h) Kt[((d * 32 + tau) * 16 + hp) * 16 + h] = accv[h];
        }
    }
    __syncthreads();
    bf16* MF = (bf16*)(F.ws + WS_MFULL) + (size_t)g * 512 * XK;
    for (int c = half * 256 * 96 + F.tid; c < (half + 1) * 256 * 96; c += NTHREADS) {
        const int row = c / 96, kc = (c % 96) * 8, j = row >> 4, hp = row & 15; float v[8];
        if (kc < 512) {
            const int s = kc >> 4, h0 = kc & 15;
#pragma unroll
            for (int e = 0; e < 8; ++e) { const int h = h0 + e; float val;
                if (j > s) val = Kt[((0 * 32 + (j - s)) * 16 + hp) * 16 + h];
                else if (s > j) val = Kt[((1 * 32 + (s - j)) * 16 + hp) * 16 + h];
                else val = Kt[((0 * 32 + 0) * 16 + hp) * 16 + h] + Kt[((1 * 32 + 0) * 16 + hp) * 16 + h] + (h == hp ? dsk[g * 16 + h] : 0.f);
                v[e] = val; }
        } else {
            const int kk = kc - 512, blk = kk >> 6, p0 = kk & 63, d = blk >> 1, tau = d ? (32 - j) : (j + 1);
#pragma unroll
            for (int e = 0; e < 8; ++e) { const f2 c2 = Cc[(d * 16 + hp) * 65 + p0 + e], w = pw[(d * 33 + tau) * 65 + p0 + e];
                v[e] = (blk & 1) ? -(c2.x * w.y + c2.y * w.x) : (c2.x * w.x - c2.y * w.y); }
        }
        u32x4 o; o.x = pk2(v[0], v[1]); o.y = pk2(v[2], v[3]); o.z = pk2(v[4], v[5]); o.w = pk2(v[6], v[7]);
        *(u32x4*)(MF + (size_t)row * XK + kc) = o;
    }
    bf16* MS = (bf16*)(F.ws + WS_MS) + (size_t)g * 256 * 512;
    for (int c = half * 128 * 64 + F.tid; c < (half + 1) * 128 * 64; c += NTHREADS) {
        const int row = c >> 6, kc = (c & 63) * 8, s = kc >> 4, h0 = kc & 15, blk = row >> 6, pp = row & 63, d = blk >> 1, tau = d ? s : (31 - s);
        const f2 w = pw[(d * 33 + tau) * 65 + pp]; float v[8];
#pragma unroll
        for (int e = 0; e < 8; ++e) { const f2 b = Bb[(d * 64 + pp) * 16 + h0 + e]; v[e] = (blk & 1) ? (w.x * b.y + w.y * b.x) : (w.x * b.x - w.y * b.y); }
        u32x4 o; o.x = pk2(v[0], v[1]); o.y = pk2(v[2], v[3]); o.z = pk2(v[4], v[5]); o.w = pk2(v[6], v[7]);
        *(u32x4*)(MS + (size_t)row * 512 + kc) = o;
    }
    __syncthreads();
}

__device__ __forceinline__ void phase0a(Frame& F, const Params& p, const int parts = 7) {
    if (parts & 1) { if (F.bx < 6 * KSL) p0_mod_item(F, p, F.bx);
    else if (F.bx >= 128) p0_s5_tables(F, p, (F.bx - 128) >> 1, (F.bx - 128) & 1); }
    __syncthreads();
    LAS float* scr = (LAS float*)(F.lds + F.wave * 16384);
    const int gw = F.bx * NWAVES + F.wave, NGW = F.G * NWAVES;
    const bool freeb = (F.bx >= 6 * KSL) && (F.bx < 128);
    const int fw = (F.bx - 6 * KSL) * NWAVES + F.wave, NFW = (128 - 6 * KSL) * NWAVES;
    constexpr int I_IN = (D / 64) * (INW / 32), I_GLU = (S5W / 64) * (S5W / 32), I_PA = (S5W / 64) * (D / 32), I_PB = I_PA, I_OUT = (D / 64) * (D / 32), I_Q = I_OUT;
    constexpr int NT1 = I_IN + I_GLU, NT1F = (NT1 * 3 / 20 / 8) * 8;
    if (parts & 2) for (int stage = 0; stage < 2; ++stage) {
        if (stage == 0 && !freeb) continue;
        const int beg = stage == 0 ? fw : NT1F + gw, end = stage == 0 ? NT1F : NT1, step = stage == 0 ? NFW : NGW;
        for (int it = beg; it < end; it += step) {
            int r = it;
            if (r < I_IN) { p0_transpose_item(p.in[7], D, INW, (bf16*)(F.ws + WS_WIN), scr, r, F.lane, true); continue; }
            p0_transpose_item(p.in[16], S5W, S5W, (bf16*)(F.ws + WS_WGLU), scr, r - I_IN, F.lane);
        }
    }
    constexpr int NT2 = 2 * 16384, NT2F = (NT2 * 3 / 20 / 8) * 8;
    if (parts & 4) for (int stage = 0; stage < 2; ++stage) {
        if (stage == 0 && !freeb) continue;
        const int beg = stage == 0 ? fw : NT2F + gw, end = stage == 0 ? NT2F : NT2, step = stage == 0 ? NFW : NGW;
        for (int it = beg; it < end; it += step) {
            const int which = it >> 14, row = it & 16383;
            const f32x4* src = (const f32x4*)(p.in[30 + which] + (size_t)row * D) + F.lane;
            f32x4 v[8];
#pragma unroll
            for (int j = 0; j < 8; ++j) v[j] = src[64 * j];
            {
                float ssq = 0.f;
#pragma unroll
                for (int j = 0; j < 8; ++j) ssq += (v[j][0] * v[j][0] + v[j][1] * v[j][1]) + (v[j][2] * v[j][2] + v[j][3] * v[j][3]);
                ssq = wave_sum(ssq, F.lane);
                const float stepq = 0.3352f * sqrtf(ssq * (1.f / D)), invs = stepq > 0.f ? 1.f / stepq : 0.f;
                unsigned char* dst4 = F.ws + (which ? WS_PV : WS_PU);
                const int nadd = (F.lane & 1) ? 16 : 8;
#pragma unroll
                for (int j = 0; j < 8; ++j) {
                    unsigned nib = 0;
#pragma unroll
                    for (int i = 0; i < 4; ++i) { int q = (int)floorf(v[j][i] * invs); q = q < -8 ? -8 : (q > 7 ? 7 : q); nib |= (unsigned)((q + nadd) & 15) << (8 * i); }
                    const unsigned other = (unsigned)__builtin_amdgcn_update_dpp(0, (int)nib, 0xB1, 0xF, 0xF, false);
                    if (!(F.lane & 1)) *(unsigned*)(dst4 + ((size_t)j * 16384 + row) * 128 + (F.lane >> 1) * 4) = nib | (other << 4);
                }
                if (F.lane == 0) ((float*)(F.ws + (which ? WS_SV : WS_SU)))[row] = stepq;
            }
        }
    }
    const int gt = F.bx * NTHREADS + F.tid, NGT = F.G * NTHREADS;
    for (int i = gt; i < 2 * 128 * 128; i += NGT) ((bf16*)(F.ws + WS_SKB))[i] = (bf16)f2bf(p.in[29][i]);
    for (int i = gt; i < 2 * 16 * 2 * 64 * 64; i += NGT) {
        const int ii = i & 63, j = (i >> 6) & 63, gate = (i >> 12) & 1, h = (i >> 13) & 15, d = i >> 17;
        const float* w = gate ? p.in[22] : p.in[20];
        ((bf16*)(F.ws + WS_LW))[i] = (bf16)f2bf(-1.4426950408889634f * w[((size_t)(d * 16 + h) * 64 + ii) * 64 + j]);
    }
}

__device__ __forceinline__ void phase_norm(Frame& F, const Params& p, int which) {
    LAS float* gs = (LAS float*)F.lds;
    LAS float* sh = (LAS float*)(F.lds + 3 * D * 4);
    const float* modp = (const float*)(F.ws + WS_MODP); float* modf = (float*)(F.ws + WS_MODF);
    const float* bada = p.in[5];
    __syncthreads();
    if (which == 0) {
        for (int i = F.tid; i < 3 * D; i += NTHREADS) {
            const int r = i / D, k = i % D; float s0 = bada[k], s1 = bada[D + k];
            for (int ks = 0; ks < KSL; ++ks) { s0 += modp[(size_t)(ks * 3 + r) * 12288 + k]; s1 += modp[(size_t)(ks * 3 + r) * 12288 + D + k]; }
            gs[i] = p.in[6][k] * (1.f + s1); sh[i] = s0;
        }
        for (int i = F.bx * NTHREADS + F.tid; i < 3 * 12288; i += F.G * NTHREADS) {
            const int r = i / 12288, c = i % 12288; float s = bada[c];
            for (int ks = 0; ks < KSL; ++ks) s += modp[(size_t)(ks * 3 + r) * 12288 + c];
            modf[i] = s;
        }
    } else {
        for (int i = F.tid; i < 2 * D; i += NTHREADS) { const int r = i / D, k = i % D; gs[i] = p.in[27][k] * (1.f + modf[r * 12288 + 4 * D + k]); sh[i] = modf[r * 12288 + 3 * D + k]; }
    }
    __syncthreads();
    const int gw = F.bx * NWAVES + F.wave, NGW = F.G * NWAVES;
    const int nrows = which == 0 ? NTOK + NCTXT : NTOK;
    for (int m = gw; m < nrows; m += NGW) {
        const float* xrow; bf16* orow; int r;
        if (which == 0) {
            if (m < NTOK) { xrow = p.in[0] + (size_t)m * D; orow = (bf16*)(F.ws + WS_NBUF) + (size_t)m * D; r = m >> 14; }
            else { xrow = p.in[2] + (size_t)(m - NTOK) * D; orow = (bf16*)(F.ws + WS_NCTX) + (size_t)(m - NTOK) * D; r = 2; }
        } else { xrow = p.in[0] + (size_t)m * D; orow = (bf16*)(F.ws + WS_NBUF) + (size_t)m * D; r = m >> 14; }
        const f32x4* xr = (const f32x4*)xrow + F.lane;
        f32x4 v[8]; float s = 0.f;
        if (which == 1) {
            const u32x2* mr = (const u32x2*)((const bf16*)(F.ws + WS_MIX) + (size_t)m * D) + F.lane;
#pragma unroll
            for (int j = 0; j < 8; ++j) { const u32x2 mw = mr[64 * j]; v[j] = (f32x4){bf_lo(mw.x), bf_hi(mw.x), bf_lo(mw.y), bf_hi(mw.y)}; }
        } else {
#pragma unroll
            for (int j = 0; j < 8; ++j) v[j] = xr[64 * j];
        }
#pragma unroll
        for (int j = 0; j < 8; ++j) s += (v[j][0] * v[j][0] + v[j][1] * v[j][1]) + (v[j][2] * v[j][2] + v[j][3] * v[j][3]);
        const float rstd = rsqrtf(wave_sum(s, F.lane) * (1.f / D) + 1e-6f);
        u32x2* o8 = (u32x2*)orow + F.lane;
        float am = 0.f;
#pragma unroll
        for (int j = 0; j < 8; ++j) {
            const f32x4 g4 = *(const LAS f32x4*)(gs + r * D + 4 * F.lane + 256 * j), s4 = *(const LAS f32x4*)(sh + r * D + 4 * F.lane + 256 * j);
            v[j] = (f32x4){v[j][0] * rstd * g4[0] + s4[0], v[j][1] * rstd * g4[1] + s4[1], v[j][2] * rstd * g4[2] + s4[2], v[j][3] * rstd * g4[3] + s4[3]};
            u32x2 o; o.x = pk2(v[j][0], v[j][1]); o.y = pk2(v[j][2], v[j][3]);
            o8[64 * j] = o;
            if (which == 0 && m < NTOK) {
                int w8 = __builtin_amdgcn_cvt_pk_fp8_f32(v[j][0], v[j][1], 0, false); w8 = __builtin_amdgcn_cvt_pk_fp8_f32(v[j][2], v[j][3], w8, true);
                ((unsigned*)(F.ws + WS_NBUF8 + (size_t)m * D))[F.lane + 64 * j] = (unsigned)w8;
            }
            am = fmaxf(am, fmaxf(fmaxf(fabsf(v[j][0]), fabsf(v[j][1])), fmaxf(fabsf(v[j][2]), fabsf(v[j][3]))));
        }
        if (which == 1) {
#pragma unroll
            for (int o = 1; o < 64; o <<= 1) am = fmaxf(am, shx(am, o, F.lane));
            const float inv = am > 0.f ? 127.f / am : 0.f;
            unsigned* fq = (unsigned*)(F.ws + WS_FQ + (size_t)m * D) + F.lane;
            int qsum = 0;
#pragma unroll
            for (int j = 0; j < 8; ++j) {
                const int q0 = (int)rintf(v[j][0] * inv), q1 = (int)rintf(v[j][1] * inv), q2 = (int)rintf(v[j][2] * inv), q3 = (int)rintf(v[j][3] * inv);
                fq[64 * j] = (unsigned)(q0 & 255) | ((unsigned)(q1 & 255) << 8) | ((unsigned)(q2 & 255) << 16) | ((unsigned)(q3 & 255) << 24);
                qsum += (q0 + q1) + (q2 + q3);
            }
#pragma unroll
            for (int o = 2; o < 64; o <<= 1) qsum += shx(qsum, o, F.lane);
            if (F.lane == 0) ((float*)(F.ws + WS_FS))[m] = am * (1.f / 127.f);
            if (F.lane < 2) ((int*)(F.ws + WS_FS + (1u << 20)))[2 * m + F.lane] = qsum;
        }
    }
}

__device__ __forceinline__ void ctx_in_gemm(Frame& F) {
    const int w = F.bx * NWAVES + F.wave; if (w >= 2048) return;
    const int rt = w >> 6, ct = w & 63, l15 = F.lane & 15, q = F.lane >> 4;
    const bf16* A = (const bf16*)(F.ws + WS_NCTX) + (size_t)(rt * 16 + l15) * D + 8 * q;
    const bf16* B0 = (const bf16*)(F.ws + WS_WIN) + (size_t)(ct * 32 + l15) * D + 8 * q;
    const bf16* B1 = B0 + (size_t)16 * D;
    f32x4 a0 = {0, 0, 0, 0}, a1 = a0;
#pragma unroll 8
    for (int ks = 0; ks < 64; ++ks) {
        const bf16x8 a = *(const bf16x8*)(A + ks * 32), b0 = *(const bf16x8*)(B0 + ks * 32), b1 = *(const bf16x8*)(B1 + ks * 32);
        a0 = __builtin_amdgcn_mfma_f32_16x16x32_bf16(a, b0, a0, 0, 0, 0); a1 = __builtin_amdgcn_mfma_f32_16x16x32_bf16(a, b1, a1, 0, 0, 0);
    }
#pragma unroll
    for (int nn = 0; nn < 2; ++nn)
#pragma unroll
        for (int r = 0; r < 4; ++r) {
            const int tc = rt * 16 + 4 * q + r, c = ct * 32 + nn * 16 + l15; const float v = nn ? a1[r] : a0[r];
            if (c < 1024) ((bf16*)(F.ws + WS_XC))[((size_t)((c >> 4) * 16 + (tc >> 5)) * 512) + (tc & 31) * 16 + (c & 15)] = (bf16)f2bf(v);
            else ((bf16*)(F.ws + WS_VC))[(size_t)tc * LRUW + (c - 1024)] = (bf16)f2bf(v);
        }
}
__device__ __forceinline__ void ctx_s5_states(Frame& F) {
    const int w = F.bx * NWAVES + F.wave; if (w >= 1024) return;
    const int g = w >> 4, ctile = w & 15, l15 = F.lane & 15, q = F.lane >> 4;
    const bf16* A = (const bf16*)(F.ws + WS_XC) + (size_t)(g * 16 + l15) * 512 + 8 * q;
    const bf16* B = (const bf16*)(F.ws + WS_MS) + (size_t)(g * 256 + ctile * 16 + l15) * 512 + 8 * q;
    f32x4 a0 = {0, 0, 0, 0};
#pragma unroll
    for (int ks = 0; ks < 16; ++ks) a0 = __builtin_amdgcn_mfma_f32_16x16x32_bf16(*(const bf16x8*)(A + ks * 32), *(const bf16x8*)(B + ks * 32), a0, 0, 0, 0);
#pragma unroll
    for (int r = 0; r < 4; ++r) ((float*)(F.ws + WS_SC))[(size_t)(g * 16 + 4 * q + r) * 256 + ctile * 16 + l15] = a0[r];
}

constexpr int LRU_WROW = 72;
__device__ __forceinline__ float fast_sigmoid(float x) { return __builtin_amdgcn_rcpf(1.f + __expf(-x)); }
template <int PASS>
__device__ __forceinline__ void lru_item(Frame& F, const LAS bf16* lw, const LAS float* prm, const LAS float* cwl, LAS float* xs, int head, int item) {
    const int rc = item & 7, col = (item >> 3) % 65, b = (item >> 3) / 65;
    int lane = F.lane; asm volatile("" : "+v"(lane));
    const int t = lane & 31, hh = lane >> 5;
    const bf16* vbase; size_t rstride;
    if (col < 64) { vbase = (const bf16*)(F.ws + WS_V) + ((size_t)(b * SEQ + col) * LRUW + head * 64); rstride = (size_t)64 * LRUW; }
    else { vbase = (const bf16*)(F.ws + WS_VC) + ((size_t)(b * CTXL) * LRUW + head * 64); rstride = LRUW; }
    const int r0 = rc * 32, r = r0 + t;
    const int q = (col < 64) ? (8 + col * 8 + rc) : rc;
    u32x4 vw[4][4];
#pragma unroll
    for (int k = 0; k < 4; ++k) {
        const int rr = r - 1 + k; const bool ok = (rr >= 0) && (rr < 256);
        const bf16* vr = vbase + (size_t)(ok ? rr : r) * rstride;
#pragma unroll
        for (int ks = 0; ks < 4; ++ks) { u32x4 w = *(const u32x4*)(vr + 16 * ks + 8 * hh); if (!ok) w = (u32x4){0u, 0u, 0u, 0u}; vw[k][ks] = w; }
    }
    float lc[2][2]; u32x4 gq[4];
    const size_t tok = (size_t)b * SEQ + (size_t)r * 64 + col;
    if (PASS == 2) {
#pragma unroll
        for (int d = 0; d < 2; ++d)
#pragma unroll
            for (int ct = 0; ct < 2; ++ct) lc[d][ct] = ((const float*)(F.ws + WS_LC))[(size_t)((b * 2 + d) * NQ + q) * 1024 + head * 64 + t + 32 * ct];
    }
    float xa[4][8];
#pragma unroll
    for (int ks = 0; ks < 4; ++ks) {
        const int ch = 16 * ks + 8 * hh;
        const f32x4 b0 = *(const LAS f32x4*)(cwl + 4 * 64 + ch), b1 = *(const LAS f32x4*)(cwl + 4 * 64 + ch + 4);
#pragma unroll
        for (int j = 0; j < 4; ++j) { xa[ks][j] = b0[j]; xa[ks][4 + j] = b1[j]; }
    }
#pragma unroll
    for (int k = 0; k < 4; ++k)
#pragma unroll
        for (int ks = 0; ks < 4; ++ks) {
            const u32x4 w = vw[k][ks]; const int ch = 16 * ks + 8 * hh;
            const f32x4 c0 = *(const LAS f32x4*)(cwl + k * 64 + ch), c1 = *(const LAS f32x4*)(cwl + k * 64 + ch + 4);
            xa[ks][0] += c0[0] * bf_lo(w.x); xa[ks][1] += c0[1] * bf_hi(w.x); xa[ks][2] += c0[2] * bf_lo(w.y); xa[ks][3] += c0[3] * bf_hi(w.y);
            xa[ks][4] += c1[0] * bf_lo(w.z); xa[ks][5] += c1[1] * bf_hi(w.z); xa[ks][6] += c1[2] * bf_lo(w.w); xa[ks][7] += c1[3] * bf_hi(w.w);
        }
    bf16x8 af[4];
#pragma unroll
    for (int ks = 0; ks < 4; ++ks) {
        u32x4 w; w.x = cvt_pk_bf16(xa[ks][0], xa[ks][1]); w.y = cvt_pk_bf16(xa[ks][2], xa[ks][3]); w.z = cvt_pk_bf16(xa[ks][4], xa[ks][5]); w.w = cvt_pk_bf16(xa[ks][6], xa[ks][7]);
        af[ks] = __builtin_bit_cast(bf16x8, w);
        *(LAS f32x4*)(xs + t * 68 + 16 * ks + 8 * hh) = (f32x4){xa[ks][0], xa[ks][1], xa[ks][2], xa[ks][3]};
        *(LAS f32x4*)(xs + t * 68 + 16 * ks + 8 * hh + 4) = (f32x4){xa[ks][4], xa[ks][5], xa[ks][6], xa[ks][7]};
    }
    if (PASS == 2) {
#pragma unroll
        for (int ks = 0; ks < 4; ++ks) gq[ks] = *(const u32x4*)((const bf16*)(F.ws + WS_GG) + tok * LRUW + head * 64 + 16 * ks + 8 * hh);
    }
    LDS_WAIT(); asm volatile("" ::: "memory");
    float xd[2][16];
#pragma unroll
    for (int ct = 0; ct < 2; ++ct)
#pragma unroll
        for (int rg = 0; rg < 16; ++rg) xd[ct][rg] = xs[((rg & 3) + 8 * (rg >> 2) + 4 * hh) * 68 + t + 32 * ct];
    float ysum[2][16];
#pragma unroll
    for (int d = 0; d < 2; ++d) {
#pragma unroll
        for (int ct = 0; ct < 2; ++ct) {
            f32x16 acc[2];
#pragma unroll
            for (int gt = 0; gt < 2; ++gt) {
                f32x16 a; for (int i = 0; i < 16; ++i) a[i] = 0.f;
                const LAS bf16* wb = lw + ((d * 2 + gt) * 64 + t + 32 * ct) * LRU_WROW + 8 * hh;
#pragma unroll
                for (int ks = 0; ks < 4; ++ks) a = __builtin_amdgcn_mfma_f32_32x32x16_bf16(af[ks], *(const LAS bf16x8*)(wb + 16 * ks), a, 0, 0, 0);
                acc[gt] = a;
            }
            const int chl = t + 32 * ct, ch = head * 64 + chl;
            float av[16], bv[16];
            {
                const float br = prm[(d * 3 + 0) * 64 + chl], bi = prm[(d * 3 + 1) * 64 + chl], c8 = prm[(d * 3 + 2) * 64 + chl];
#pragma unroll
                for (int rg = 0; rg < 16; ++rg) {
                    const float rr = __builtin_amdgcn_rcpf(1.f + __builtin_amdgcn_exp2f(acc[0][rg] + br)), ii = __builtin_amdgcn_rcpf(1.f + __builtin_amdgcn_exp2f(acc[1][rg] + bi));
                    const float a = __builtin_amdgcn_exp2f(c8 * rr), om = fmaf(-a, a, 1.f);
                    av[rg] = a; bv[rg] = __builtin_amdgcn_sqrtf(fmaxf(om, 0.f)) * (ii * xd[ct][rg]);
                }
            }
            float hl[16], cp[16], sA[4], sB[4];
#pragma unroll
            for (int q4 = 0; q4 < 4; ++q4) {
                if (d == 0) {
                    hl[4 * q4] = bv[4 * q4]; cp[4 * q4] = av[4 * q4];
#pragma unroll
                    for (int i = 1; i < 4; ++i) { hl[4 * q4 + i] = av[4 * q4 + i] * hl[4 * q4 + i - 1] + bv[4 * q4 + i]; cp[4 * q4 + i] = av[4 * q4 + i] * cp[4 * q4 + i - 1]; }
                    sA[q4] = cp[4 * q4 + 3]; sB[q4] = hl[4 * q4 + 3];
                } else {
                    hl[4 * q4 + 3] = bv[4 * q4 + 3]; cp[4 * q4 + 3] = av[4 * q4 + 3];
#pragma unroll
                    for (int i = 2; i >= 0; --i) { hl[4 * q4 + i] = av[4 * q4 + i] * hl[4 * q4 + i + 1] + bv[4 * q4 + i]; cp[4 * q4 + i] = av[4 * q4 + i] * cp[4 * q4 + i + 1]; }
                    sA[q4] = cp[4 * q4]; sB[q4] = hl[4 * q4];
                }
            }
            float Ae[4], Be[4], Ao[4], Bo[4];
#pragma unroll
            for (int q4 = 0; q4 < 4; ++q4) {
                const float oA = shx(sA[q4], 32, lane), oB = shx(sB[q4], 32, lane);
                Ae[q4] = hh ? oA : sA[q4]; Be[q4] = hh ? oB : sB[q4]; Ao[q4] = hh ? sA[q4] : oA; Bo[q4] = hh ? sB[q4] : oB;
            }
            if (PASS == 1) {
                float c = 0.f, P = 1.f;
                if (d == 0) {
#pragma unroll
                    for (int q4 = 0; q4 < 4; ++q4) { c = Ae[q4] * c + Be[q4]; c = Ao[q4] * c + Bo[q4]; P *= Ae[q4] * Ao[q4]; } }
                else {
#pragma unroll
                    for (int q4 = 3; q4 >= 0; --q4) { c = Ao[q4] * c + Bo[q4]; c = Ae[q4] * c + Be[q4]; P *= Ae[q4] * Ao[q4]; } }
                if (hh == 0) { float* o = (float*)(F.ws + WS_PL) + ((size_t)((b * 2 + d) * NQ + q) * 1024 + ch) * 2; o[0] = P; o[1] = c; }
            } else {
                float cin[4];
                float c = lc[d][ct];
                if (d == 0) {
#pragma unroll
                    for (int q4 = 0; q4 < 4; ++q4) { const float c0 = c; c = Ae[q4] * c + Be[q4]; const float c1 = c; c = Ao[q4] * c + Bo[q4]; cin[q4] = hh ? c1 : c0; } }
                else {
#pragma unroll
                    for (int q4 = 3; q4 >= 0; --q4) { const float c0 = c; c = Ao[q4] * c + Bo[q4]; const float c1 = c; c = Ae[q4] * c + Be[q4]; cin[q4] = hh ? c0 : c1; } }
#pragma unroll
                for (int rg = 0; rg < 16; ++rg) { const float hv = hl[rg] + cp[rg] * cin[rg >> 2]; if (d == 0) ysum[ct][rg] = hv; else ysum[ct][rg] += hv; }
            }
        }
    }
    if (PASS == 2) {
#pragma unroll
        for (int ct = 0; ct < 2; ++ct)
#pragma unroll
            for (int rg = 0; rg < 16; ++rg) xs[((rg & 3) + 8 * (rg >> 2) + 4 * hh) * 68 + t + 32 * ct] = ysum[ct][rg];
        LDS_WAIT(); asm volatile("" ::: "memory");
        bf16* yb = (bf16*)(F.ws + WS_YB) + tok * LRUW + head * 64;
#pragma unroll
        for (int ks = 0; ks < 4; ++ks) {
            const int c0 = 16 * ks + 8 * hh; const u32x4 g4 = gq[ks];
            const f32x4 y0 = *(const LAS f32x4*)(xs + t * 68 + c0), y1 = *(const LAS f32x4*)(xs + t * 68 + c0 + 4);
            u32x4 o; o.x = cvt_pk_bf16(y0[0] * bf_lo(g4.x), y0[1] * bf_hi(g4.x)); o.y = cvt_pk_bf16(y0[2] * bf_lo(g4.y), y0[3] * bf_hi(g4.y));
            o.z = cvt_pk_bf16(y1[0] * bf_lo(g4.z), y1[1] * bf_hi(g4.z)); o.w = cvt_pk_bf16(y1[2] * bf_lo(g4.w), y1[3] * bf_hi(g4.w));
            *(u32x4*)(yb + c0) = o;
        }
    }
    LDS_WAIT(); asm volatile("" ::: "memory");
}

template <int PASS>
__device__ __forceinline__ void lru_phase(Frame& F, const Params& p) {
    LAS bf16* lw = (LAS bf16*)F.lds;
    LAS float* prm = (LAS float*)(F.lds + 36864);
    LAS float* cwl = (LAS float*)(F.lds + 36864 + 1536);
    LAS float* xs = (LAS float*)(F.lds + 40960 + F.wave * (32 * 68 * 4));
    const int head = F.bx & 15;
    __syncthreads();
    for (int i = F.tid; i < 4 * 64 * 8; i += NTHREADS) {
        const int c = i & 7, j = (i >> 3) & 63, m = i >> 9, d = m >> 1, gt = m & 1;
        const u32x4 w = *(const u32x4*)((const bf16*)(F.ws + WS_LW) + ((size_t)(((d * 16 + head) * 2 + gt) * 64 + j) * 64 + 8 * c));
        *(LAS u32x4*)(lw + (m * 64 + j) * LRU_WROW + 8 * c) = w;
    }
    for (int i = F.tid; i < 2 * 64; i += NTHREADS) {
        const int d = i >> 6, c = i & 63, ch = head * 64 + c; const float lam = p.in[19][d * LRUW + ch];
        prm[(d * 3 + 0) * 64 + c] = -1.4426950408889634f * p.in[21][d * LRUW + ch]; prm[(d * 3 + 1) * 64 + c] = -1.4426950408889634f * p.in[23][d * LRUW + ch];
        prm[(d * 3 + 2) * 64 + c] = 1.4426950408889634f * -8.f * (lam > 15.f ? __expf(-lam) : log1pf(__expf(-lam)));
    }
    for (int i = F.tid; i < 5 * 64; i += NTHREADS) { const int k = i >> 6, c = i & 63; cwl[i] = (k < 4) ? p.in[17][k * LRUW + head * 64 + c] : p.in[18][head * 64 + c]; }
    __syncthreads();
    const int wg = (F.bx >> 4) * NWAVES + F.wave, NWG = (F.G >> 4) * NWAVES;
    const int nitems = 2 * 65 * 8;
    for (int it = wg; it < nitems; it += NWG) {
        if (PASS == 2 && ((it >> 3) % 65) == 64) continue;
        lru_item<PASS>(F, lw, prm, cwl, xs, head, it);
    }
    __syncthreads();
}

__device__ __forceinline__ void phase_carry(Frame& F, const Params& p) {
    if (F.bx < 32) {
        const int id = F.bx * NTHREADS + F.tid, pp = id & 63, d = (id >> 6) & 1, g = (id >> 7) & 63, b = id >> 13;
        const float lr = p.in[8][(d * 64 + g) * 64 + pp], li = p.in[9][(d * 64 + g) * 64 + pp], dt = __expf(p.in[10][d * 64 + g]);
        const float mag = expf(32.f * dt * lr); float sn, cs; sincosf(32.f * dt * li, &sn, &cs); const float ar = mag * cs, ai = mag * sn;
        const float* SC = (const float*)(F.ws + WS_SC) + (size_t)(g * 16 + b * 8) * 256 + d * 128 + pp;
        const float* SB = (const float*)(F.ws + WS_SBUF) + (size_t)(g * NCHUNK + b * 512) * 256 + d * 128 + pp;
        bf16* X = (bf16*)(F.ws + WS_X) + (size_t)(g * NCHUNK + b * 512) * XK + 512 + d * 128 + pp;
        float hr = 0.f, hi = 0.f;
        if (d == 0) {
            for (int c = 0; c < 8; ++c) { const float sr = SC[c * 256], si = SC[c * 256 + 64]; const float nr = ar * hr - ai * hi + sr; hi = ar * hi + ai * hr + si; hr = nr; }
            for (int n0 = 0; n0 < 512; n0 += 8) {
                float sr[8], si[8];
#pragma unroll
                for (int u = 0; u < 8; ++u) { sr[u] = SB[(size_t)(n0 + u) * 256]; si[u] = SB[(size_t)(n0 + u) * 256 + 64]; }
#pragma unroll
                for (int u = 0; u < 8; ++u) { X[(size_t)(n0 + u) * XK] = (bf16)f2bf(hr); X[(size_t)(n0 + u) * XK + 64] = (bf16)f2bf(hi);
                    const float nr = ar * hr - ai * hi + sr[u]; hi = ar * hi + ai * hr + si[u]; hr = nr; }
            }
        } else {
            for (int c = 7; c >= 0; --c) { const float sr = SC[c * 256], si = SC[c * 256 + 64]; const float nr = ar * hr - ai * hi + sr; hi = ar * hi + ai * hr + si; hr = nr; }
            for (int n0 = 504; n0 >= 0; n0 -= 8) {
                float sr[8], si[8];
#pragma unroll
                for (int u = 0; u < 8; ++u) { sr[u] = SB[(size_t)(n0 + u) * 256]; si[u] = SB[(size_t)(n0 + u) * 256 + 64]; }
#pragma unroll
                for (int u = 7; u >= 0; --u) { X[(size_t)(n0 + u) * XK] = (bf16)f2bf(hr); X[(size_t)(n0 + u) * XK + 64] = (bf16)f2bf(hi);
                    const float nr = ar * hr - ai * hi + sr[u]; hi = ar * hi + ai * hr + si[u]; hr = nr; }
            }
        }
    } else if (F.bx < 40) {
        const int id = (F.bx - 32) * NTHREADS + F.tid, ch = id & 1023, d = (id >> 10) & 1, b = id >> 11;
        const float* PL = (const float*)(F.ws + WS_PL) + ((size_t)(b * 2 + d) * NQ * 1024 + ch) * 2;
        float* LC = (float*)(F.ws + WS_LC) + (size_t)(b * 2 + d) * NQ * 1024 + ch;
        float h = 0.f;
        if (d == 0) {
            for (int q = 0; q < 8; ++q) { h = PL[(size_t)q * 2048] * h + PL[(size_t)q * 2048 + 1]; }
            for (int q0 = 8; q0 < NQ; q0 += 8) {
                float P[8], L[8];
#pragma unroll
                for (int u = 0; u < 8; ++u) { P[u] = PL[(size_t)(q0 + u) * 2048]; L[u] = PL[(size_t)(q0 + u) * 2048 + 1]; }
#pragma unroll
                for (int u = 0; u < 8; ++u) { LC[(size_t)(q0 + u) * 1024] = h; h = P[u] * h + L[u]; }
            }
        } else {
            for (int q = 7; q >= 0; --q) { h = PL[(size_t)q * 2048] * h + PL[(size_t)q * 2048 + 1]; }
            for (int q0 = NQ - 8; q0 >= 8; q0 -= 8) {
                float P[8], L[8];
#pragma unroll
                for (int u = 0; u < 8; ++u) { P[u] = PL[(size_t)(q0 + u) * 2048]; L[u] = PL[(size_t)(q0 + u) * 2048 + 1]; }
#pragma unroll
                for (int u = 7; u >= 0; --u) { LC[(size_t)(q0 + u) * 1024] = h; h = P[u] * h + L[u]; }
            }
        }
    } else {
        LAS float* scr = (LAS float*)(F.lds + F.wave * 16384);
        constexpr int I_PA = (S5W / 64) * (D / 32), I_PB = I_PA, I_OUT = (D / 64) * (D / 32), I_Q = I_OUT;
        for (int it = (F.bx - 40) * NWAVES + F.wave; it < I_PA + I_PB + I_OUT + I_Q; it += (F.G - 40) * NWAVES) {
            int r = it;
            if (r < I_PA) { p0_transpose_item(p.in[24], S5W, D, (bf16*)(F.ws + WS_WPA), scr, r, F.lane); continue; } r -= I_PA;
            if (r < I_PB) { p0_transpose_item(p.in[25], LRUW, D, (bf16*)(F.ws + WS_WPB), scr, r, F.lane); continue; } r -= I_PB;
            if (r < I_OUT) { p0_transpose_item(p.in[26], D, D, (bf16*)(F.ws + WS_WOUT), scr, r, F.lane); continue; } r -= I_OUT;
            p0_transpose_item(p.in[28], D, D, (bf16*)(F.ws + WS_WQ), scr, r, F.lane);
        }
    }
}

constexpr unsigned char c_cand[50] = {
    0x00,0x01,0x02,0x03,0x04,0x05,0x06,0x07,0x08,0x09,0x0a,0x0b,0x0c,0x0d,0x0e,0x0f, 0x10,0x11,0x12,0x13,0x14,0x15,0x16,0x17, 0x20,
    0x21,0x22,0x23,0x24, 0x30,0x31,0x32,0x33, 0x40,0x41,0x42, 0x50,0x51, 0x60,0x61, 0x70,0x71, 0x80,0x90,0xa0,0xb0,0xc0,0xd0,0xe0,0xf0 };

__device__ __forceinline__ float umax_f(float a, float b) { return fmaxf(a, b); }

__device__ __forceinline__ float vmaxf(float a, float b) { float r; asm("v_max_f32 %0, %1, %2" : "=v"(r) : "v"(a), "v"(b)); return r; }
__device__ __forceinline__ float vminf(float a, float b) { float r; asm("v_min_f32 %0, %1, %2" : "=v"(r) : "v"(a), "v"(b)); return r; }
__device__ __forceinline__ void ce_desc(float& a, float& b) { const float hi = vmaxf(a, b), lo = vminf(a, b); a = hi; b = lo; }
constexpr unsigned char c_sort16[60] = {
    0x0d,0x1c,0x2f,0x3e,0x48,0x56,0x7b,0x9a, 0x05,0x17,0x29,0x34,0x6d,0x8e,0xaf,0xbc, 0x01,0x23,0x45,0x68,0x79,0xab,0xcd,0xef, 0x02,0x13,0x4a,0x5b,0x67,0x89,0xce,0xdf,
    0x12,0x3c,0x46,0x57,0x8a,0x9b,0xde, 0x14,0x26,0x58,0x7a,0x9d,0xbe, 0x24,0x36,0x9c,0xbd, 0x35,0x68,0x79,0xac, 0x34,0x56,0x78,0x9a,0xbc, 0x67,0x89 };
__device__ __forceinline__ void sort16_desc(float (&a)[16]) {
#pragma unroll
    for (int n = 0; n < 60; ++n) ce_desc(a[c_sort16[n] >> 4], a[c_sort16[n] & 15]);
}
__device__ __forceinline__ void merge_top16(float (&a)[16], const float (&b)[16]) {
#pragma unroll
    for (int i = 0; i < 16; ++i) a[i] = vmaxf(a[i], b[15 - i]);
#pragma unroll
    for (int j = 8; j > 0; j >>= 1)
#pragma unroll
        for (int i = 0; i < 16; ++i) { const int l = i ^ j; if (l > i) ce_desc(a[i], a[l]); }
}


__device__ __forceinline__ void peer_phase(Frame& F, const Params& p, const int parts = 7) {
    LAS int* sel_e = (LAS int*)F.lds; LAS float* sel_g = (LAS float*)(F.lds + 16640);
    LAS unsigned* tk = (LAS unsigned*)(F.lds + 33280);
    LAS unsigned char* skl = F.lds + 67072;
    const bf16* Q = (const bf16*)(F.ws + WS_Q); const bf16* SK = (const bf16*)(F.ws + WS_SKB);
    const bf16* FB = (const bf16*)(F.ws + WS_NBUF); const unsigned char* PU = F.ws + WS_PU; const unsigned char* PV = F.ws + WS_PV;
    const float* SU = (const float*)(F.ws + WS_SU); const float* SV = (const float*)(F.ws + WS_SV);
    const float* modf = (const float*)(F.ws + WS_MODF);
    const int lane = F.lane, t = lane & 31, hh = lane >> 5, head = F.wave;
    const unsigned NEG = 0xff800000u;
    __syncthreads();
    for (int i = F.tid; i < 256 * 16; i += NTHREADS) *(LAS u32x4*)(skl + (i >> 4) * 272 + (i & 15) * 16) = *(const u32x4*)(SK + (size_t)(i >> 4) * 128 + (i & 15) * 8);
    bf16x8 qf[8];
    if (F.bx < NTOK / 32) {
        const bf16* qp = Q + (size_t)(F.bx * 32 + t) * D + head * 256 + 8 * hh;
#pragma unroll
        for (int ks = 0; ks < 8; ++ks) qf[ks] = *(const bf16x8*)(qp + 16 * ks);
    }
    for (int tile = F.bx; tile < NTOK / 32; tile += F.G) {
        const int tok0 = tile * 32;
        __syncthreads();
        if (parts & 1) {
        LAS unsigned* mytk = tk + (size_t)(t * 8 + head) * 33;
#pragma unroll 1
        for (int side = 0; side < 2; ++side) {
            unsigned pk[64];
            {
                f32x16 acc[4];
#pragma unroll
                for (int kb = 0; kb < 4; ++kb) for (int i = 0; i < 16; ++i) acc[kb][i] = 0.f;
                const LAS unsigned char* sp = skl + (side * 128 + t) * 272 + 16 * hh;
#pragma unroll
                for (int ks = 0; ks < 8; ++ks) {
#pragma unroll
                    for (int kb = 0; kb < 4; ++kb) {
                        const bf16x8 sf = *(const LAS bf16x8*)(sp + kb * (32 * 272) + 32 * ks);
                        acc[kb] = __builtin_amdgcn_mfma_f32_32x32x16_bf16(sf, qf[ks], acc[kb], 0, 0, 0);
                    }
                }
                {
                    const int ntile = side ? tile + F.G : tile;
                    if (ntile < NTOK / 32) {
                        const bf16* qn = Q + (size_t)(ntile * 32 + t) * D + head * 256 + (side ^ 1) * 128 + 8 * hh;
#pragma unroll
                        for (int ks = 0; ks < 8; ++ks) qf[ks] = *(const bf16x8*)(qn + 16 * ks);
                    }
                }
#pragma unroll
                for (int kb = 0; kb < 4; ++kb)
#pragma unroll
                    for (int rg = 0; rg < 16; ++rg) pk[kb * 16 + rg] = (__float_as_uint(acc[kb][rg]) & ~0x7fu) | (unsigned)(kb * 32 + (rg & 3) + 8 * (rg >> 2) + 4 * hh);
            }
            {
                float g0[16], g1[16];
#pragma unroll
                for (int i = 0; i < 16; ++i) { g0[i] = __uint_as_float(pk[i]); g1[i] = __uint_as_float(pk[16 + i]); }
                sort16_desc(g0); sort16_desc(g1); merge_top16(g0, g1);
#pragma unroll
                for (int i = 0; i < 16; ++i) g1[i] = __uint_as_float(pk[32 + i]);
                sort16_desc(g1); merge_top16(g0, g1);
#pragma unroll
                for (int i = 0; i < 16; ++i) g1[i] = __uint_as_float(pk[48 + i]);
                sort16_desc(g1); merge_top16(g0, g1);
#pragma unroll
                for (int i = 0; i < 16; ++i) g1[i] = shx(g0[i], 32, lane);
                merge_top16(g0, g1);
                if (hh == 0) {
#pragma unroll
                    for (int i = 0; i < 16; ++i) mytk[side * 16 + i] = __float_as_uint(g0[i]);
                }
            }
        }
        LDS_WAIT(); asm volatile("" ::: "memory");
        {
            unsigned cd[25];
            {
                unsigned w0[16], w1[16];
#pragma unroll
                for (int i = 0; i < 16; ++i) { w0[i] = mytk[i]; w1[i] = mytk[16 + i]; }
#pragma unroll
                for (int n = 0; n < 25; ++n) {
                    const int idA = c_cand[n], idB = c_cand[25 + n];
                    const float vA = __uint_as_float(w0[idA >> 4] & ~0x7fu) + __uint_as_float(w1[idA & 15] & ~0x7fu);
                    const float vB = __uint_as_float(w0[idB >> 4] & ~0x7fu) + __uint_as_float(w1[idB & 15] & ~0x7fu);
                    cd[n] = hh ? ((__float_as_uint(vB) & ~0xffu) | (unsigned)idB) : ((__float_as_uint(vA) & ~0xffu) | (unsigned)idA);
                }
            }
            float c0[16], c1[16];
#pragma unroll
            for (int i = 0; i < 16; ++i) { c0[i] = __uint_as_float(cd[i]); c1[i] = (i < 9) ? __uint_as_float(cd[16 + i]) : __uint_as_float(NEG); }
            sort16_desc(c0); sort16_desc(c1); merge_top16(c0, c1);
#pragma unroll
            for (int i = 0; i < 16; ++i) c1[i] = shx(c0[i], 32, lane);
            merge_top16(c0, c1);
            float sc[16]; int ex[16];
#pragma unroll
            for (int rd = 0; rd < 16; ++rd) {
                const unsigned mb = __float_as_uint(c0[rd]);
                const unsigned w0 = mytk[(mb >> 4) & 15], w1 = mytk[16 + (mb & 15)];
                sc[rd] = __uint_as_float(w0 & ~0x7fu) + __uint_as_float(w1 & ~0x7fu);
                ex[rd] = (int)((w0 & 0x7fu) * 128u + (w1 & 0x7fu));
            }
            float mx = sc[0];
#pragma unroll
            for (int i = 1; i < 16; ++i) mx = fmaxf(mx, sc[i]);
            float sum = 0.f;
#pragma unroll
            for (int i = 0; i < 16; ++i) { sc[i] = __expf(sc[i] - mx); sum += sc[i]; }
            const float inv = 1.f / sum;
            if (hh == 0) {
#pragma unroll
                for (int i = 0; i < 16; ++i) { sel_e[t * 129 + head * 16 + i] = ex[i]; sel_g[t * 129 + head * 16 + i] = sc[i] * inv * SV[ex[i]]; }
            }
        }
        }
        __syncthreads();
        if (parts & 2) for (int i = F.tid; i < 32 * 128; i += NTHREADS) {
            const size_t gi = (size_t)tok0 * 128 + i;
            const int pp = i & 127, li = (i >> 7) * 129 + pp; ((int*)(F.ws + WS_SELE))[gi - pp + (pp & 7) * 16 + (pp >> 3)] = sel_e[li]; ((float*)(F.ws + WS_SELG))[gi] = sel_g[li]; ((float*)(F.ws + WS_SELU))[gi] = SU[sel_e[li]];
        }
    }
}

struct PeerVisit { u32x4 e[4]; u32x4 x, x2; float sc; int cs; };
template <bool VPASS>
__device__ __forceinline__ PeerVisit visit_load(const unsigned char* ws, const unsigned char* FQc, int tok, int lane) {
    PeerVisit v; const int pg = lane >> 3;
    const u32x4* ep = (const u32x4*)((const int*)(ws + WS_SELE) + (size_t)tok * 128 + pg * 16);
#pragma unroll
    for (int q = 0; q < 4; ++q) v.e[q] = ep[q];
    if (VPASS) { v.x = *(const u32x4*)(ws + WS_CFQ + (size_t)tok * 128 + pg * 16); v.x2 = v.x; v.sc = ((const float*)(ws + WS_CS))[2 * tok]; v.cs = ((const int*)(ws + WS_CS))[2 * tok + 1]; }
    else { const u32x4* fp = (const u32x4*)(FQc + (size_t)tok * D + (lane & 7) * 32); v.x = fp[0]; v.x2 = fp[1]; v.sc = 0.f; v.cs = 0; }
    return v;
}
__device__ __forceinline__ void rows16_load(u32x4 (&w)[16], const unsigned char* T, const PeerVisit& v, int lane) {
    const int pc = (lane & 7) * 16;
#pragma unroll
    for (int q = 0; q < 4; ++q) {
        w[4 * q + 0] = *(const u32x4*)(T + (v.e[q].x * 128u + (unsigned)pc)); w[4 * q + 1] = *(const u32x4*)(T + (v.e[q].y * 128u + (unsigned)pc));
        w[4 * q + 2] = *(const u32x4*)(T + (v.e[q].z * 128u + (unsigned)pc)); w[4 * q + 3] = *(const u32x4*)(T + (v.e[q].w * 128u + (unsigned)pc));
    }
}
__device__ __forceinline__ int dpp_add8(int v) {
    v += __builtin_amdgcn_update_dpp(0, v, 0xB1, 0xF, 0xF, false);
    v += __builtin_amdgcn_update_dpp(0, v, 0x4E, 0xF, 0xF, false);
    v += __builtin_amdgcn_update_dpp(0, v, 0x141, 0xF, 0xF, false);
    return v;
}
__device__ __forceinline__ void u_compute(const u32x4 (&w)[16], const PeerVisit& v, int* pd, int lane) {
    const int pg = lane >> 3, sub = lane & 7;
    int d[16];
#pragma unroll
    for (int it = 0; it < 16; ++it) {
        int tl = 0, th = 0;
        tl = __builtin_amdgcn_sdot4((int)(w[it].x & 0x0F0F0F0Fu), (int)v.x.x, tl, false);  th = __builtin_amdgcn_sdot4((int)(w[it].x & 0xF0F0F0F0u), (int)v.x.y, th, false);
        tl = __builtin_amdgcn_sdot4((int)(w[it].y & 0x0F0F0F0Fu), (int)v.x.z, tl, false);  th = __builtin_amdgcn_sdot4((int)(w[it].y & 0xF0F0F0F0u), (int)v.x.w, th, false);
        tl = __builtin_amdgcn_sdot4((int)(w[it].z & 0x0F0F0F0Fu), (int)v.x2.x, tl, false); th = __builtin_amdgcn_sdot4((int)(w[it].z & 0xF0F0F0F0u), (int)v.x2.y, th, false);
        tl = __builtin_amdgcn_sdot4((int)(w[it].w & 0x0F0F0F0Fu), (int)v.x2.z, tl, false); th = __builtin_amdgcn_sdot4((int)(w[it].w & 0xF0F0F0F0u), (int)v.x2.w, th, false);
        const int t = tl * 16 + th;
        d[it] = dpp_add8(t);
    }
    int v0 = d[0], v1 = d[8];
#pragma unroll
    for (int it = 1; it < 8; ++it) { v0 = (sub == it) ? d[it] : v0; v1 = (sub == it) ? d[8 + it] : v1; }
    pd[sub * 8 + pg] = v0; pd[64 + sub * 8 + pg] = v1;
}
typedef int i32x4v __attribute__((ext_vector_type(4)));
__device__ __forceinline__ void v_compute(const u32x4 (&w)[16], const PeerVisit& v, bf16* po, int lane) {
    i32x4v a1[4], a2[4];
#pragma unroll
    for (int q = 0; q < 4; ++q) { a1[q] = (i32x4v){0, 0, 0, 0}; a2[q] = (i32x4v){0, 0, 0, 0}; }
    const unsigned cq[4] = {v.x.x, v.x.y, v.x.z, v.x.w};
    unsigned selq[4];
#pragma unroll
    for (int sI = 0; sI < 4; ++sI) selq[sI] = 0x0C0C0C0Cu ^ ((0x0Cu ^ (unsigned)sI) << (8 * (lane & 3)));
#pragma unroll
    for (int it = 0; it < 16; ++it) {
        const int A = (int)__builtin_amdgcn_perm(0u, cq[it >> 2], selq[it & 3]);
#pragma unroll
        for (int q = 0; q < 4; ++q) {
            a1[q] = __builtin_amdgcn_mfma_i32_4x4x4i8(A, (int)w[it][q], a1[q], 0, 0, 0);
            a2[q] = __builtin_amdgcn_mfma_i32_4x4x4i8(A, (int)(w[it][q] & 0xF0F0F0F0u), a2[q], 0, 0, 0);
        }
    }
    int r1[2][4], r2[2][4];
#pragma unroll
    for (int jj = 0; jj < 2; ++jj)
#pragma unroll
        for (int i = 0; i < 4; ++i) {
            const auto t1 = __builtin_amdgcn_permlane32_swap((unsigned)a1[jj][i], (unsigned)a1[jj + 2][i], false, false); r1[jj][i] = (int)t1[0] + (int)t1[1];
            const auto t2 = __builtin_amdgcn_permlane32_swap((unsigned)a2[jj][i], (unsigned)a2[jj + 2][i], false, false); r2[jj][i] = (int)t2[0] + (int)t2[1];
        }
    int s1[4], s2[4];
#pragma unroll
    for (int i = 0; i < 4; ++i) {
        const auto t1 = __builtin_amdgcn_permlane16_swap((unsigned)r1[0][i], (unsigned)r1[1][i], false, false); s1[i] = (int)t1[0] + (int)t1[1];
        const auto t2 = __builtin_amdgcn_permlane16_swap((unsigned)r2[0][i], (unsigned)r2[1][i], false, false); s2[i] = (int)t2[0] + (int)t2[1];
        s1[i] += __builtin_amdgcn_update_dpp(0, s1[i], 0x128, 0xF, 0xF, false);
        s2[i] += __builtin_amdgcn_update_dpp(0, s2[i], 0x128, 0xF, 0xF, false);
    }
    if (!(lane & 8)) {
        const float csf = (float)v.cs; float lo[4], hi[4];
#pragma unroll
        for (int i = 0; i < 4; ++i) { lo[i] = ((float)(s1[i] - s2[i]) - 7.5f * csf) * v.sc; hi[i] = ((float)s2[i] * 0.0625f + 0.5f * csf) * v.sc; }
        u32x4 o;
        o.x = cvt_pk_bf16(lo[0], lo[1]); o.y = cvt_pk_bf16(lo[2], lo[3]); o.z = cvt_pk_bf16(hi[0], hi[1]); o.w = cvt_pk_bf16(hi[2], hi[3]);
        *(u32x4*)(po + (lane & 7) * 32 + 8 * (((lane >> 4) & 1) + 2 * (lane >> 5))) = o;
    }
}
template <bool VPASS>
__device__ __forceinline__ void peer_pass(Frame& F, int c, int rank, int nblk) {
    const unsigned char* T = F.ws + (VPASS ? WS_PV : WS_PU) + (size_t)c * 16384 * 128; const unsigned char* FQc = F.ws + WS_FQ + c * 256;
    int* PD = (int*)(F.ws + WS_PD) + (size_t)c * NTOK * 128; bf16* PO = (bf16*)(F.ws + WS_PO) + c * 256;
    const int t0 = rank * NWAVES + F.wave, step = nblk * NWAVES;
    if (t0 >= NTOK) return;
    const int nvis = (NTOK - t0 + step - 1) / step;
    int lane = F.lane; asm volatile("" : "+v"(lane));
    PeerVisit va = visit_load<VPASS>(F.ws, FQc, t0, lane), vb = va;
    u32x4 wa[16], wb[16];
    rows16_load(wa, T, va, lane);
    if (nvis > 1) vb = visit_load<VPASS>(F.ws, FQc, t0 + step, lane);
#pragma unroll 1
    for (int v = 0; v < nvis; v += 2) {
        const int tok = t0 + v * step;
        asm volatile("" : "+v"(lane));
        PeerVisit vn = va;
        if (v + 1 < nvis) rows16_load(wb, T, vb, lane);
        if (v + 2 < nvis) vn = visit_load<VPASS>(F.ws, FQc, tok + 2 * step, lane);
        if (VPASS) v_compute(wa, va, PO + (size_t)tok * D, lane); else u_compute(wa, va, PD + (size_t)tok * 128, lane);
        if (v + 1 < nvis) {
            PeerVisit vm = vb;
            if (v + 2 < nvis) rows16_load(wa, T, vn, lane);
            if (v + 3 < nvis) vm = visit_load<VPASS>(F.ws, FQc, tok + 3 * step, lane);
            if (VPASS) v_compute(wb, vb, PO + (size_t)(tok + step) * D, lane); else u_compute(wb, vb, PD + (size_t)(tok + step) * 128, lane);
            vb = vm;
        }
        va = vn;
    }
}
struct CfIn { int d0[8], d1[8]; float fs; int s0, s1; float u0, u1, g0, g1; };
__device__ __forceinline__ void cf_load(CfIn& r, const unsigned char* ws, int tok, int lane) {
#pragma unroll
    for (int c = 0; c < 8; ++c) { const int* pd = (const int*)(ws + WS_PD) + ((size_t)c * NTOK + tok) * 128; r.d0[c] = pd[lane]; r.d1[c] = pd[64 + lane]; }
    r.fs = ((const float*)(ws + WS_FS))[tok]; r.s0 = ((const int*)(ws + WS_FS + (1u << 20)))[2 * tok]; r.s1 = ((const int*)(ws + WS_FS + (1u << 20)))[2 * tok + 1];
    r.u0 = ((const float*)(ws + WS_SELU))[(size_t)tok * 128 + lane]; r.u1 = ((const float*)(ws + WS_SELU))[(size_t)tok * 128 + 64 + lane];
    r.g0 = ((const float*)(ws + WS_SELG))[(size_t)tok * 128 + lane]; r.g1 = ((const float*)(ws + WS_SELG))[(size_t)tok * 128 + 64 + lane];
}
__device__ __forceinline__ void peer_cf(Frame& F) {
    const int lane = F.lane, gw = F.bx * NWAVES + F.wave, NGW = F.G * NWAVES;
    CfIn rn;
    if (gw < NTOK) cf_load(rn, F.ws, gw, lane);
    for (int tok = gw; tok < NTOK; tok += NGW) {
        const CfIn r = rn;
        if (tok + NGW < NTOK) cf_load(rn, F.ws, tok + NGW, lane);
        int d0 = 0, d1 = 0;
#pragma unroll
        for (int c = 0; c < 8; ++c) { d0 += r.d0[c]; d1 += r.d1[c]; }
        const float foff = 7.5f * (float)r.s0 - 0.5f * (float)r.s1;
        const float c0 = r.g0 * gelu_f(((float)d0 * 0.0625f - foff) * (r.u0 * r.fs)), c1 = r.g1 * gelu_f(((float)d1 * 0.0625f - foff) * (r.u1 * r.fs));
        float am = fmaxf(fabsf(c0), fabsf(c1));
#pragma unroll
        for (int o = 1; o < 64; o <<= 1) am = fmaxf(am, shx(am, o, lane));
        const float inv = am > 0.f ? 127.f / am : 0.f;
        const int q0 = (int)rintf(c0 * inv), q1 = (int)rintf(c1 * inv);
        unsigned char* cq = F.ws + WS_CFQ + (size_t)tok * 128;
        cq[(lane & 7) * 16 + (lane >> 3)] = (unsigned char)(q0 & 255); cq[(lane & 7) * 16 + 8 + (lane >> 3)] = (unsigned char)(q1 & 255);
        int qs = q0 + q1;
#pragma unroll
        for (int o = 1; o < 64; o <<= 1) qs += shx(qs, o, lane);
        if (lane == 0) { ((float*)(F.ws + WS_CS))[2 * tok] = am * (1.f / 127.f); ((int*)(F.ws + WS_CS))[2 * tok + 1] = qs; }
    }
}
struct FinalRow { u32x2 m[8], q[8]; };
__device__ __forceinline__ void final_row_load(FinalRow& r, const Params& p, const unsigned char* ws, int tok, int lane) {
    const bf16* mrow = (const bf16*)(ws + WS_MIX) + (size_t)tok * D; const bf16* prow = (const bf16*)(ws + WS_PO) + (size_t)tok * D;
#pragma unroll
    for (int j = 0; j < 8; ++j) { const int el = 4 * lane + 256 * j; r.m[j] = *(const u32x2*)(mrow + el); r.q[j] = *(const u32x2*)(prow + el); }
}
__device__ __forceinline__ void peer_final(Frame& F, const Params& p) {
    const float* modf = (const float*)(F.ws + WS_MODF);
    const int lane = F.lane, gw = F.bx * NWAVES + F.wave, NGW = F.G * NWAVES;
    FinalRow rn;
    if (gw < NTOK) final_row_load(rn, p, F.ws, gw, lane);
    for (int tok = gw; tok < NTOK; tok += NGW) {
        FinalRow r = rn;
        if (tok + NGW < NTOK) final_row_load(rn, p, F.ws, tok + NGW, lane);
        float* hrow = p.out + (size_t)tok * D;
        const float* m5 = modf + (size_t)(tok >> 14) * 12288 + 5 * D; float ss = 0.f;
        f32x4 v[8];
#pragma unroll
        for (int j = 0; j < 8; ++j) {
            const int el = 4 * lane + 256 * j; const f32x4 g4 = *(const f32x4*)(m5 + el);
            const float mf[4] = {bf_lo(r.m[j].x), bf_hi(r.m[j].x), bf_lo(r.m[j].y), bf_hi(r.m[j].y)}, pf[4] = {bf_lo(r.q[j].x), bf_hi(r.q[j].x), bf_lo(r.q[j].y), bf_hi(r.q[j].y)};
#pragma unroll
            for (int i = 0; i < 4; ++i) { const float t = mf[i] + g4[i] * pf[i]; v[j][i] = t; ss += t * t; }
        }
        const float rstd = rsqrtf(wave_sum(ss, lane) * (1.f / D) + 1e-6f);
#pragma unroll
        for (int j = 0; j < 8; ++j) {
            const int el = 4 * lane + 256 * j; const f32x4 gf = *(const f32x4*)(p.in[32] + el);
            *(f32x4*)(hrow + el) = (f32x4){v[j][0] * rstd * gf[0], v[j][1] * rstd * gf[1], v[j][2] * rstd * gf[2], v[j][3] * rstd * gf[3]};
        }
    }
}

#ifndef DUPMASK
#define DUPMASK 0
#endif
#define REFRESH() do { F.lane = lane_id(); F.tid = F.wave * 64 + F.lane; } while (0)
#define RUNPH(n, ...) do { REFRESH(); { __VA_ARGS__ } if ((DUPMASK >> (n)) & 1) { grid.sync(); REFRESH(); { __VA_ARGS__ } } } while (0)
__global__ void __launch_bounds__(NTHREADS, 2) fwd_megakernel(Params p) {
    extern __shared__ __attribute__((aligned(16))) unsigned char lds_raw[];
    cg::grid_group grid = cg::this_grid();
    Frame F; F.lds = (LAS unsigned char*)lds_raw; F.tid = threadIdx.x; F.lane = F.tid & 63; F.wave = __builtin_amdgcn_readfirstlane(F.tid >> 6); F.G = gridDim.x; F.bx = blockIdx.x; F.ws = p.ws;
    volatile LAS unsigned* bst = (volatile LAS unsigned*)(F.lds + LDS_BYTES - 16);
    if (F.tid < 4) bst[F.tid] = 0u;
    __syncthreads();
    const XcdBarrier xbar = xcd_barrier_post((unsigned*)(p.ws), bst, F.tid == 0);
    if (F.tid == 0) { bst[2] = xb_add((unsigned*)p.ws + CW_RANK + 64 * xbar.x, 1u); bst[3] = xb_add((unsigned*)p.ws + CW_TICKET, 1u); }
#define GSYNC() xcd_barrier(xbar, (F.wave == 0) && (lane_id() == 0))

    RUNPH(0, phase0a(F, p););
    if (DUPMASK & 0x700000) { grid.sync(); REFRESH(); phase0a(F, p, (DUPMASK >> 20) & 7); }
    if (p.out == nullptr) grid.sync();
    GSYNC();
    RUNPH(1, phase_norm(F, p, 0););
    GSYNC();
    RUNPH(2, ctx_in_gemm(F); big_gemm(F, p, pg8::EM_IN, F.ws + WS_NBUF, D, F.ws + WS_WIN, D, NTOK, 3072, D);
        REFRESH();
        pg8::Sched S; S.A = (const char*)(F.ws + WS_NBUF8); S.B = (const char*)(F.ws + WS_WIN8); S.gA = 0; S.gB = 0; S.lda = D; S.ldb = D; S.nM = NTOK / 256; S.nN = 4096 / 256; S.nG = 1; S.G = F.G; S.c = F.bx;
        S.A2 = S.A; S.B2 = S.B; S.pair = 0; S.esz = 1;
        pg8::Epi E; E.mode = pg8::EM_ING; E.ws = F.ws; E.x = p.in[0]; E.out = p.out; E.modf = (const float*)(F.ws + WS_MODF);
        pg8::gemm_phase<true>(F.lds, D, S, E, F.wave););
    if (DUPMASK & 0x8000) { GSYNC(); REFRESH(); big_gemm(F, p, pg8::EM_PROBE, F.ws + WS_NBUF, D, F.ws + WS_WIN, D, NTOK, D, D); }
    GSYNC();
    RUNPH(3,
        pg8::Sched S; S.A = (const char*)(F.ws + WS_X); S.B = (const char*)(F.ws + WS_MS); S.gA = (size_t)NCHUNK * XK * 2; S.gB = (size_t)256 * 512 * 2; S.lda = XK; S.ldb = 512; S.nM = 4; S.nN = 1; S.nG = 64; S.G = F.G; S.c = F.bx; S.A2 = S.A; S.B2 = S.B; S.pair = 0; S.esz = 2;
        pg8::Epi E; E.mode = pg8::EM_S5S; E.ws = F.ws; E.x = p.in[0]; E.out = p.out; E.modf = (const float*)(F.ws + WS_MODF);
        pg8::gemm_phase(F.lds, 512, S, E, F.wave);
        REFRESH(); ctx_s5_states(F);
        lru_phase<1>(F, p); if (DUPMASK & 0x1000) { GSYNC(); REFRESH(); lru_phase<1>(F, p); });
    GSYNC();
    RUNPH(4, phase_carry(F, p););
    GSYNC();
    RUNPH(5,
        pg8::Sched S; S.A = (const char*)(F.ws + WS_X); S.B = (const char*)(F.ws + WS_MFULL); S.gA = (size_t)NCHUNK * XK * 2; S.gB = (size_t)512 * XK * 2; S.lda = XK; S.ldb = XK; S.nM = 4; S.nN = 2; S.nG = 64; S.G = F.G; S.c = F.bx; S.A2 = S.A; S.B2 = S.B; S.pair = 0; S.esz = 2;
        pg8::Epi E; E.mode = pg8::EM_S5Y; E.ws = F.ws; E.x = p.in[0]; E.out = p.out; E.modf = (const float*)(F.ws + WS_MODF);
        pg8::gemm_phase(F.lds, XK, S, E, F.wave);
        REFRESH(); lru_phase<2>(F, p); if (DUPMASK & 0x2000) { GSYNC(); REFRESH(); lru_phase<2>(F, p); });
    GSYNC();
    RUNPH(6, big_gemm(F, p, pg8::EM_GLU, F.ws + WS_ZA, S5W, F.ws + WS_WGLU, S5W, NTOK, S5W, S5W););
    GSYNC();
    RUNPH(7,
        pg8::Sched S; S.A = (const char*)(F.ws + WS_YA); S.B = (const char*)(F.ws + WS_WPA); S.A2 = (const char*)(F.ws + WS_YB); S.B2 = (const char*)(F.ws + WS_WPB); S.pair = 1; S.esz = 2;
        S.gA = 0; S.gB = 0; S.lda = S5W; S.ldb = S5W; S.nM = NTOK / 256; S.nN = D / 256; S.nG = 1; S.G = F.G; S.c = F.bx;
        pg8::Epi E; E.mode = pg8::EM_PAB; E.ws = F.ws; E.x = p.in[0]; E.out = p.out; E.modf = (const float*)(F.ws + WS_MODF);
        pg8::gemm_phase(F.lds, S5W, S, E, F.wave););
    GSYNC();
    RUNPH(8, big_gemm(F, p, pg8::EM_OUT, F.ws + WS_NBUF, D, F.ws + WS_WOUT, D, NTOK, D, D););
    GSYNC();
    RUNPH(9, phase_norm(F, p, 1););
    GSYNC();
    RUNPH(10, big_gemm(F, p, pg8::EM_Q, F.ws + WS_NBUF, D, F.ws + WS_WQ, D, NTOK, D, D););
    GSYNC();
    if (DUPMASK & 0x4000) { for (int i = 0; i < 10; ++i) GSYNC(); }
    REFRESH(); peer_phase(F, p);
    if (DUPMASK & 0x8000) { GSYNC(); REFRESH(); peer_phase(F, p, (DUPMASK >> 24) & 7); }
    GSYNC();
    {
        int sp, rank, nblk;
        {
            unsigned* bar = (unsigned*)p.ws; bool ok = true; unsigned mine = 0;
            for (unsigned j = 0; j < 16; ++j) { const unsigned cnt = xb_ld(&bar[XB_XCNT(j)]); if ((j < 8) != (cnt > 0u)) ok = false; if (j == xbar.x) mine = cnt; }
            const unsigned tk = bst[3];
            if (ok) { sp = (int)xbar.x; rank = (int)bst[2]; nblk = (int)mine; }
            else { sp = (int)(tk & 7u); rank = (int)(tk >> 3); nblk = (int)((F.G + 7 - (tk & 7u)) / 8); }
            sp = __builtin_amdgcn_readfirstlane(sp); rank = __builtin_amdgcn_readfirstlane(rank); nblk = __builtin_amdgcn_readfirstlane(nblk);
        }
        REFRESH(); peer_pass<false>(F, sp, rank, nblk);
        if (DUPMASK & 0x10000) { GSYNC(); REFRESH(); peer_pass<false>(F, sp, rank, nblk); }
        GSYNC();
        REFRESH(); peer_cf(F);
        if (DUPMASK & 0x20000) { GSYNC(); REFRESH(); peer_cf(F); }
        GSYNC();
        REFRESH(); peer_pass<true>(F, sp, rank, nblk);
        if (DUPMASK & 0x40000) { GSYNC(); REFRESH(); peer_pass<true>(F, sp, rank, nblk); }
        GSYNC();
        REFRESH(); peer_final(F, p);
        if (DUPMASK & 0x80000) { GSYNC(); REFRESH(); peer_final(F, p); }
    }
}

extern "C" void kernel_launch(void* const* d_in, const int* in_sizes, int n_in, void* d_out, int out_size, void* d_ws, size_t ws_size, hipStream_t stream) {
    static int grid_blocks = 0;
    if (!grid_blocks) {
        int dev = 0, cus = 0, per_cu = 0;
        (void)hipGetDevice(&dev);
        (void)hipDeviceGetAttribute(&cus, hipDeviceAttributeMultiprocessorCount, dev);
        (void)hipFuncSetAttribute((const void*)fwd_megakernel, hipFuncAttributeMaxDynamicSharedMemorySize, LDS_BYTES);
        (void)hipOccupancyMaxActiveBlocksPerMultiprocessor(&per_cu, (const void*)fwd_megakernel, NTHREADS, LDS_BYTES);
        if (per_cu < 1) per_cu = 1;
        grid_blocks = cus;
        if (ws_size < WS_END) { fprintf(stderr, "kernel_launch: workspace too small (%zu < %zu)\n", ws_size, (size_t)WS_END); grid_blocks = -1; }
    }
    if (grid_blocks < 0) return;
    (void)hipMemsetAsync(d_ws, 0, 65536, stream);
    Params p{};
    for (int i = 0; i < 33; ++i) p.in[i] = (const float*)d_in[i];
    p.out = (float*)d_out; p.ws = (unsigned char*)d_ws;
    void* args[] = {&p};
    hipError_t e = hipLaunchCooperativeKernel((const void*)fwd_megakernel, dim3(grid_blocks), dim3(NTHREADS), args, LDS_BYTES, stream);
    if (e != hipSuccess) fprintf(stderr, "cooperative launch failed: %s (grid %d)\n", hipGetErrorString(e), grid_blocks);
}
```

```cpp
#include <hip/hip_runtime.h>
#include <hip/hip_cooperative_groups.h>
#include <cstdio>
#include <cstdint>
namespace cg = cooperative_groups;

#define LAS __attribute__((address_space(3)))
typedef unsigned short bf16;
typedef short bf16x8 __attribute__((ext_vector_type(8)));
typedef float f32x4 __attribute__((ext_vector_type(4)));
typedef float f32x16 __attribute__((ext_vector_type(16)));
typedef unsigned u32x4 __attribute__((ext_vector_type(4)));
typedef unsigned u32x2 __attribute__((ext_vector_type(2)));

constexpr int D = 2048, NB = 2, SEQ = 16384, NTOK = NB * SEQ, CTXL = 256, NCTXT = NB * CTXL;
constexpr int S5W = 1024, LRUW = 1024, INW = 7168;
constexpr int NTHREADS = 512, NWAVES = 8;
constexpr int LDS_BYTES = 147456;
constexpr int TCH = 32;
constexpr int NCHUNK = NTOK / TCH;
constexpr int XK = 768;
constexpr int NQ = 520;
constexpr int KSL = 16;

constexpr size_t MiB = 1ull << 20;
constexpr size_t WS_MODP = 1 * MiB;
constexpr size_t WS_MODF = 6 * MiB;
constexpr size_t WS_WIN = 8 * MiB;
constexpr size_t WS_WIN8 = WS_WIN + (size_t)3072 * 4096;
constexpr size_t WS_NBUF8 = 864 * MiB;
constexpr size_t WS_WGLU = 36 * MiB;
constexpr size_t WS_WPA = 38 * MiB;
constexpr size_t WS_WPB = 42 * MiB;
constexpr size_t WS_WOUT = 46 * MiB;
constexpr size_t WS_WQ = 54 * MiB;
constexpr size_t WS_SKB = 62 * MiB;
constexpr size_t WS_LW = 63 * MiB;
constexpr size_t WS_MFULL = 64 * MiB;
constexpr size_t WS_MS = 112 * MiB;
constexpr size_t WS_PU = 128 * MiB;
constexpr size_t WS_PV = 160 * MiB;
constexpr size_t WS_SU = 192 * MiB;
constexpr size_t WS_SV = 192 * MiB + 65536;
constexpr size_t WS_NBUF = 256 * MiB;
constexpr size_t WS_SBUF = 256 * MiB;
constexpr size_t WS_PL = 320 * MiB;
constexpr size_t WS_LC = 338 * MiB;
constexpr size_t WS_X = 384 * MiB;
constexpr size_t WS_YA = 384 * MiB;
constexpr size_t WS_V = 480 * MiB;
constexpr size_t WS_GG = 544 * MiB;
constexpr size_t WS_SA = 608 * MiB;
constexpr size_t WS_Q = 608 * MiB;
constexpr size_t WS_SB = 736 * MiB;
constexpr size_t WS_MIX = 736 * MiB;
constexpr size_t WS_ZA = 864 * MiB;
constexpr size_t WS_YB = 928 * MiB;
constexpr size_t WS_NCTX = 992 * MiB;
constexpr size_t WS_XC = 994 * MiB;
constexpr size_t WS_VC = 995 * MiB;
constexpr size_t WS_SC = 996 * MiB;
constexpr size_t WS_SELE = 194 * MiB;
constexpr size_t WS_SELG = 210 * MiB;
constexpr size_t WS_SELU = 226 * MiB;
constexpr size_t WS_FQ = 384 * MiB;
constexpr size_t WS_FS = 448 * MiB;
constexpr size_t WS_PD = 480 * MiB;
constexpr size_t WS_CFQ = 864 * MiB;
constexpr size_t WS_CS = 880 * MiB;
constexpr size_t WS_PO = 256 * MiB;
constexpr size_t WS_END = 1024 * MiB;
constexpr int CW_RANK = 4096;
constexpr int CW_TICKET = 8192;

struct Params {
    const float* in[33];
    float* out;
    unsigned char* ws;
};

__device__ __forceinline__ unsigned f2bf(float f) { unsigned u = __float_as_uint(f); return (u + 0x7fffu + ((u >> 16) & 1u)) >> 16; }
__device__ __forceinline__ unsigned pk2(float lo, float hi) { return f2bf(lo) | (f2bf(hi) << 16); }
__device__ __forceinline__ unsigned cvt_pk_bf16(float lo, float hi) { unsigned r; asm volatile("v_cvt_pk_bf16_f32 %0, %1, %2" : "=v"(r) : "v"(lo), "v"(hi)); return r; }
__device__ __forceinline__ float bf_lo(unsigned w) { return __uint_as_float(w << 16); }
__device__ __forceinline__ float bf_hi(unsigned w) { return __uint_as_float(w & 0xffff0000u); }
__device__ __forceinline__ float sigmoid_f(float x) { return __builtin_amdgcn_rcpf(1.f + __expf(-x)); }
__device__ __forceinline__ float gelu_f(float x) { const float u = 1.5957691216057308f * (x + 0.044715f * x * x * x); return x * __builtin_amdgcn_rcpf(1.f + __expf(-u)); }
__device__ __forceinline__ float shx(float v, int o, int lane) { return __int_as_float(__builtin_amdgcn_ds_bpermute((lane ^ o) << 2, __float_as_int(v))); }
__device__ __forceinline__ int shx(int v, int o, int lane) { return __builtin_amdgcn_ds_bpermute((lane ^ o) << 2, v); }
__device__ __forceinline__ float wave_sum(float v, int lane) {
#pragma unroll
    for (int o = 1; o < 64; o <<= 1) v += shx(v, o, lane);
    return v;
}
#define LDS_WAIT() asm volatile("s_waitcnt lgkmcnt(0)" ::: "memory")
__device__ __forceinline__ int lane_id() { int l; asm volatile("v_mbcnt_lo_u32_b32 %0, -1, 0\n\tv_mbcnt_hi_u32_b32 %0, -1, %0" : "=v"(l)); return l; }
__device__ __forceinline__ int opaque_tid(int wave_s) { return wave_s * 64 + lane_id(); }

namespace pg8 {
constexpr int BM = 256, BK = 64, HALF = 128, HTB = HALF * BK * 2, STAGE_BYTES = 8 * HTB, NXCD = 8, WGM = 8;
__device__ __forceinline__ int lds_byte(int r, int c) { const int st = (r >> 4) * 2 + (c >> 5), rr = r & 15, cc = c & 31, ob = rr * 64 + cc * 2; return st * 1024 + (ob ^ (((ob >> 9) & 1) << 5)); }
__device__ __forceinline__ void stage_rc(int b, int& R, int& C) { const int st = b / 1024, sb = b % 1024, swz = sb ^ (((sb >> 9) & 1) << 5); R = (st >> 1) * 16 + swz / 64; C = (st & 1) * 32 + (swz % 64) / 2; }
__device__ __forceinline__ int perm32(int rho) { const int n = rho >> 4, i = rho & 15; return 8 * (i >> 2) + 4 * n + (i & 3); }

struct Unit { const char* A; const char* B; int g, pm, pn, ph; };

struct Sched {
    const char* A; const char* B; size_t gA, gB; int lda, ldb, nM, nN, nG, G, c;
    const char* A2; const char* B2; int pair; int esz;
    __device__ __forceinline__ bool next(int i0, Unit& u) const {
        const int i = pair ? (i0 >> 1) : i0; u.ph = pair ? (i0 & 1) : 0;
        const long L = (long)i * G + c; const int per = nM * nN; if (L >= (long)per * nG) return false;
        const int g = (int)(L / per); int wgid = (int)(L % per); int pm, pn;
        if (nG == 1) {
            const int nwg = per; { const int q = nwg / NXCD, r = nwg % NXCD, xcd = wgid % NXCD, off = wgid / NXCD; wgid = (xcd < r ? xcd * (q + 1) : r * (q + 1) + (xcd - r) * q) + off; }
            const int nig = WGM * nN, gid = wgid / nig, fm = gid * WGM, gsz = (nM - fm) < WGM ? (nM - fm) : WGM;
            pm = fm + ((wgid % nig) % gsz); pn = (wgid % nig) / gsz;
        } else { pm = wgid % nM; pn = wgid / nM; }
        u.g = g; u.pm = pm; u.pn = pn;
        u.A = (u.ph ? A2 : A) + (size_t)g * gA + (size_t)pm * BM * lda * esz; u.B = (u.ph ? B2 : B) + (size_t)g * gB + (size_t)pn * BM * ldb * esz;
        return true;
    }
};

enum EpiMode { EM_IN = 0, EM_ING, EM_S5S, EM_S5Y, EM_GLU, EM_PAB, EM_OUT, EM_Q, EM_PROBE };
struct Epi {
    int mode;
    unsigned char* ws; const float* x; float* out; const float* modf;
    __device__ __forceinline__ void store8(bf16* p, const float (&v)[8]) const {
        u32x4 w; w.x = cvt_pk_bf16(v[0], v[1]); w.y = cvt_pk_bf16(v[2], v[3]); w.z = cvt_pk_bf16(v[4], v[5]); w.w = cvt_pk_bf16(v[6], v[7]);
        *(u32x4*)p = w;
    }
    __device__ __forceinline__ void gate(f32x4 (&acc)[2][2][4][2], const Unit& u, int wr, int wc, int fr, int fq) const {
#pragma unroll
            for (int ai = 0; ai < 2; ++ai)
#pragma unroll
                for (int m = 0; m < 4; ++m) {
                    const int row = u.pm * BM + ai * HALF + wr * 64 + m * 16 + fr, dcol = u.pn * HALF + wc * 32 + 8 * fq;
                    float ra[8], sb[8];
#pragma unroll
                    for (int j = 0; j < 8; ++j) {
                        const float za = acc[ai][0][m][j >> 2][j & 3], zb = fmaxf(acc[ai][1][m][j >> 2][j & 3], -30.f * 64.f);
                        const float ea = __builtin_amdgcn_exp2f(za * (-1.4426950408889634f / 64.f)), eb = __builtin_amdgcn_exp2f(zb * (-1.4426950408889634f / 64.f));
                        sb[j] = __builtin_amdgcn_rcpf(1.f + eb);
                        ra[j] = (1.f + eb) * __builtin_amdgcn_rcpf(1.f + ea);
                    }
                    store8((bf16*)(ws + WS_SA) + (size_t)row * D + dcol, ra);
                    store8((bf16*)(ws + WS_SB) + (size_t)row * D + dcol, sb);
                }
    }
    __device__ __forceinline__ void operator()(f32x4 (&acc)[2][2][4][2], const Unit& u, int wr, int wc, int fr, int fq) const {
        if (mode == EM_GLU || mode == EM_PAB) {
            const int ld = (mode == EM_GLU) ? S5W : D;
            const bf16* g0 = (const bf16*)(ws + (mode == EM_GLU ? WS_ZA : (u.ph == 0 ? WS_SA : WS_SB)));
            u32x4 zq[2][4][2];
#pragma unroll
            for (int ai = 0; ai < 2; ++ai)
#pragma unroll
                for (int m = 0; m < 4; ++m)
#pragma unroll
                    for (int bj = 0; bj < 2; ++bj) {
                        const int row = u.pm * BM + ai * HALF + wr * 64 + m * 16 + fr, col = u.pn * BM + bj * HALF + wc * 32 + 8 * fq;
                        zq[ai][m][bj] = *(const u32x4*)(g0 + (size_t)row * ld + col);
                    }
#pragma unroll
            for (int ai = 0; ai < 2; ++ai) {
#pragma unroll
                for (int m = 0; m < 4; ++m)
#pragma unroll
                    for (int bj = 0; bj < 2; ++bj) {
                        const int row = u.pm * BM + ai * HALF + wr * 64 + m * 16 + fr, col = u.pn * BM + bj * HALF + wc * 32 + 8 * fq;
                        const u32x4 z = zq[ai][m][bj];
                        const float zf[8] = {bf_lo(z.x), bf_hi(z.x), bf_lo(z.y), bf_hi(z.y), bf_lo(z.z), bf_hi(z.z), bf_lo(z.w), bf_hi(z.w)};
                        if (mode == EM_PAB && u.ph == 0) {
#pragma unroll
                            for (int j = 0; j < 4; ++j) { acc[ai][bj][m][0][j] *= zf[j]; acc[ai][bj][m][1][j] *= zf[4 + j]; }
                        } else {
                            float v[8];
#pragma unroll
                            for (int j = 0; j < 4; ++j) { v[j] = acc[ai][bj][m][0][j]; v[4 + j] = acc[ai][bj][m][1][j]; }
                            if (mode == EM_GLU) {
#pragma unroll
                                for (int j = 0; j < 8; ++j) v[j] = zf[j] * sigmoid_f(v[j]);
                                store8((bf16*)(ws + WS_YA) + (size_t)row * S5W + col, v);
                            } else {
#pragma unroll
                                for (int j = 0; j < 8; ++j) v[j] *= zf[j];
                                store8((bf16*)(ws + WS_NBUF) + (size_t)row * D + col, v);
                            }
                        }
                    }
            }
            return;
        }
        if (mode == EM_OUT) {
            const float* m2 = modf + (size_t)((u.pm * BM) >> 14) * 12288 + 2 * D;
            f32x4 gq[2][2];
#pragma unroll
            for (int bj = 0; bj < 2; ++bj) { const int col = u.pn * BM + bj * HALF + wc * 32 + 8 * fq; gq[bj][0] = *(const f32x4*)(m2 + col); gq[bj][1] = *(const f32x4*)(m2 + col + 4); }
#pragma unroll
            for (int ai = 0; ai < 2; ++ai) {
                f32x4 xq[4][2][2];
#pragma unroll
                for (int m = 0; m < 4; ++m)
#pragma unroll
                    for (int bj = 0; bj < 2; ++bj) {
                        const int row = u.pm * BM + ai * HALF + wr * 64 + m * 16 + fr, col = u.pn * BM + bj * HALF + wc * 32 + 8 * fq;
                        xq[m][bj][0] = *(const f32x4*)(x + (size_t)row * D + col); xq[m][bj][1] = *(const f32x4*)(x + (size_t)row * D + col + 4);
                    }
#pragma unroll
                for (int m = 0; m < 4; ++m)
#pragma unroll
                    for (int bj = 0; bj < 2; ++bj) {
                        const int row = u.pm * BM + ai * HALF + wr * 64 + m * 16 + fr, col = u.pn * BM + bj * HALF + wc * 32 + 8 * fq;
                        float v[8];
#pragma unroll
                        for (int j = 0; j < 4; ++j) { v[j] = xq[m][bj][0][j] + gq[bj][0][j] * acc[ai][bj][m][0][j]; v[4 + j] = xq[m][bj][1][j] + gq[bj][1][j] * acc[ai][bj][m][1][j]; }
                        store8((bf16*)(ws + WS_MIX) + (size_t)row * D + col, v);
                    }
            }
            return;
        }
#pragma unroll
        for (int ai = 0; ai < 2; ++ai)
#pragma unroll
            for (int m = 0; m < 4; ++m) {
                const int row = u.pm * BM + ai * HALF + wr * 64 + m * 16 + fr;
#pragma unroll
                for (int bj = 0; bj < 2; ++bj) {
                    const int col = u.pn * BM + bj * HALF + wc * 32 + 8 * fq;
                    float v[8];
#pragma unroll
                    for (int j = 0; j < 4; ++j) { v[j] = acc[ai][bj][m][0][j]; v[4 + j] = acc[ai][bj][m][1][j]; }
                    if (mode == EM_IN) {
                        if (u.pn < 4) {
                            const int g = col >> 4, h0 = col & 15;
                            bf16* p = (bf16*)(ws + WS_X) + ((size_t)(g * NCHUNK + (row >> 5)) * XK + (row & 31) * 16 + h0);
                            store8(p, v);
                        } else if (u.pn < 8) {
                            store8((bf16*)(ws + WS_V) + (size_t)row * LRUW + (col - 1024), v);
                        } else {
#pragma unroll
                            for (int j = 0; j < 8; ++j) v[j] = gelu_f(v[j]);
                            store8((bf16*)(ws + WS_GG) + (size_t)row * LRUW + (col - 2048), v);
                        }
                    } else if (mode == EM_S5S) {
                        float* p = (float*)(ws + WS_SBUF) + ((size_t)(u.g * NCHUNK + row) * 256 + col);
                        *(f32x4*)p = (f32x4){v[0], v[1], v[2], v[3]}; *(f32x4*)(p + 4) = (f32x4){v[4], v[5], v[6], v[7]};
                    } else if (mode == EM_S5Y) {
                        const int tok = row * TCH + (col >> 4), ch = u.g * 16 + (col & 15);
#pragma unroll
                        for (int j = 0; j < 8; ++j) v[j] = gelu_f(v[j]);
                        store8((bf16*)(ws + WS_ZA) + (size_t)tok * S5W + ch, v);
                    } else if (mode == EM_PROBE) {
                        asm volatile("" :: "v"(v[0]), "v"(v[1]), "v"(v[2]), "v"(v[3]), "v"(v[4]), "v"(v[5]), "v"(v[6]), "v"(v[7]));
                    } else {
                        store8((bf16*)(ws + WS_Q) + (size_t)row * D + col, v);
                    }
                }
            }
    }
};

typedef int i32x4g __attribute__((ext_vector_type(4)));
typedef int i32x8g __attribute__((ext_vector_type(8)));
__device__ __forceinline__ i32x8g cat8(const bf16x8& lo, const bf16x8& hi) { return __builtin_shufflevector(__builtin_bit_cast(i32x4g, lo), __builtin_bit_cast(i32x4g, hi), 0, 1, 2, 3, 4, 5, 6, 7); }
template <bool F8 = false>
__device__ __forceinline__ void gemm_phase(LAS unsigned char* lds, const int K, const Sched& S, const Epi& E, const int wave_s) {
    const int tid = opaque_tid(wave_s), wid = wave_s, lane = tid & 63, wr = wid >> 2, wc = wid & 3, fr = lane & 15, fq = lane >> 4;
    const int nt = F8 ? K / (2 * BK) : K / BK, lda = F8 ? S.lda / 2 : S.lda, ldb = F8 ? S.ldb / 2 : S.ldb;
    const bool align = true;
    unsigned voffA[2], voffB[2];
#pragma unroll
    for (int i = 0; i < 2; ++i) { int R, C; stage_rc(tid * 16 + i * 8192, R, C); const int Rb = (R & ~31) + perm32(R & 31);
        voffA[i] = (unsigned)(R * lda + C) * 2u; voffB[i] = (unsigned)(Rb * ldb + C) * 2u;
        if (E.mode == EM_PROBE) { voffA[i] = voffB[i] = (unsigned)(tid * 16 + i * 8192); } }
    const size_t kstep = (E.mode == EM_PROBE) ? (size_t)32768 : (size_t)(BK * 2);
    const size_t hstepA = (E.mode == EM_PROBE) ? (size_t)16384 : (size_t)HALF * lda * 2, hstepB = (E.mode == EM_PROBE) ? (size_t)16384 : (size_t)HALF * ldb * 2;
    const unsigned ldsw = (unsigned)wid * 1024u;
    const int aoff = lds_byte(wr * 64 + fr, fq * 8), boff = lds_byte(wc * 32 + fr, fq * 8);
#define PG8_SA(b, h) (((b) * 2 + (h)) * HTB)
#define PG8_SB(b, h) ((4 + (b) * 2 + (h)) * HTB)
#define PG8_STAGE(bufoff, gbase, voff) do { _Pragma("unroll") for (int _i = 0; _i < 2; ++_i) { unsigned _vo = (voff)[_i]; asm volatile("" : "+v"(_vo));   \
        __builtin_amdgcn_global_load_lds((const unsigned*)((const char*)(gbase) + _vo), (LAS unsigned*)(lds + (bufoff) + ldsw + _i * 8192), 16, 0, 0); } } while (0)
#define PG8_LDA(dst, b, h) do { _Pragma("unroll") for (int m = 0; m < 4; ++m) _Pragma("unroll") for (int k = 0; k < 2; ++k) dst[m][k] = *(const LAS bf16x8*)(lds + PG8_SA(b, h) + aoff + m * 2048 + k * 1024); } while (0)
#define PG8_LDB(dst, b, h) do { _Pragma("unroll") for (int n = 0; n < 2; ++n) _Pragma("unroll") for (int k = 0; k < 2; ++k) dst[n][k] = *(const LAS bf16x8*)(lds + PG8_SB(b, h) + boff + n * 2048 + k * 1024); } while (0)
#define PG8_MMA(ai, bj, At, Bt) do { __builtin_amdgcn_s_setprio(1); \
        if (F8) { _Pragma("unroll") for (int m = 0; m < 4; ++m) _Pragma("unroll") for (int n = 0; n < 2; ++n) \
            acc[ai][bj][m][n] = __builtin_amdgcn_mfma_scale_f32_16x16x128_f8f6f4(cat8(Bt[n][0], Bt[n][1]), cat8(At[m][0], At[m][1]), acc[ai][bj][m][n], 0, 0, 0, 0, 0, 0); } \
        else { _Pragma("unroll") for (int m = 0; m < 4; ++m) _Pragma("unroll") for (int n = 0; n < 2; ++n) _Pragma("unroll") for (int k = 0; k < 2; ++k) \
            acc[ai][bj][m][n] = __builtin_amdgcn_mfma_f32_16x16x32_bf16(Bt[n][k], At[m][k], acc[ai][bj][m][n], 0, 0, 0); } \
        __builtin_amdgcn_s_setprio(0); } while (0)
#define PG8_WAIT_V(n) asm volatile("s_waitcnt vmcnt(" #n ")" ::: "memory")
#define PG8_WAIT_L(n) asm volatile("s_waitcnt lgkmcnt(" #n ")" ::: "memory")
#define PG8_BAR __builtin_amdgcn_s_barrier()
#define PG8_SCHED __builtin_amdgcn_sched_barrier(0)
    Unit cur, nxt; int ui = 0;
    if (!S.next(0, cur)) return;
    f32x4 acc[2][2][4][2];
#pragma unroll
    for (int a = 0; a < 2; ++a)
#pragma unroll
        for (int b = 0; b < 2; ++b)
#pragma unroll
            for (int m = 0; m < 4; ++m)
#pragma unroll
                for (int n = 0; n < 2; ++n) acc[a][b][m][n] = (f32x4){0.f, 0.f, 0.f, 0.f};
    bf16x8 At[4][2], B0[2][2], B1[2][2];
    const char* cA = cur.A; const char* cB = cur.B;
    PG8_STAGE(PG8_SB(0, 0), cB, voffB); PG8_STAGE(PG8_SB(0, 1), cB + hstepB, voffB); PG8_STAGE(PG8_SA(0, 0), cA, voffA); PG8_STAGE(PG8_SA(0, 1), cA + hstepA, voffA);
    if (wr == 1) PG8_BAR;
    PG8_WAIT_V(2); PG8_BAR;
    PG8_STAGE(PG8_SB(1, 0), cB + kstep, voffB); PG8_STAGE(PG8_SA(1, 0), cA + kstep, voffA); PG8_STAGE(PG8_SB(1, 1), cB + hstepB + kstep, voffB);
    PG8_WAIT_V(6); PG8_BAR;
    for (;;) {
        const bool has_next = S.next(ui + 1, nxt);
        const char* nA = has_next ? nxt.A : cA; const char* nB = has_next ? nxt.B : cB;
        for (int t = 0; t < nt; t += 2) {
            const bool last = (t == nt - 2);
            const char* a1 = cA + (size_t)(t + 1) * kstep;
            const char* a2 = last ? nA : cA + (size_t)(t + 2) * kstep; const char* b2 = last ? nB : cB + (size_t)(t + 2) * kstep;
            const char* a3 = a2 + kstep; const char* b3 = b2 + kstep;
            PG8_LDB(B0, 0, 0); PG8_LDB(B1, 0, 1); PG8_SCHED; PG8_LDA(At, 0, 0); PG8_STAGE(PG8_SA(1, 1), a1 + hstepA, voffA);
            PG8_WAIT_V(8); PG8_WAIT_L(0); PG8_BAR; PG8_MMA(0, 0, At, B0); PG8_MMA(0, 1, At, B1); PG8_BAR; PG8_SCHED;
            PG8_LDA(At, 0, 1); PG8_STAGE(PG8_SB(0, 0), b2, voffB); PG8_STAGE(PG8_SB(0, 1), b2 + hstepB, voffB); PG8_STAGE(PG8_SA(0, 0), a2, voffA);
            PG8_WAIT_V(8); PG8_WAIT_L(0); PG8_BAR; PG8_MMA(1, 0, At, B0); PG8_MMA(1, 1, At, B1); PG8_BAR; PG8_SCHED;
            PG8_LDB(B0, 1, 0); PG8_LDB(B1, 1, 1); PG8_SCHED; PG8_LDA(At, 1, 0); PG8_STAGE(PG8_SA(0, 1), a2 + hstepA, voffA);
            PG8_WAIT_V(8); PG8_WAIT_L(0); PG8_BAR; PG8_MMA(0, 0, At, B0); PG8_MMA(0, 1, At, B1); PG8_BAR; PG8_SCHED;
            PG8_LDA(At, 1, 1); PG8_STAGE(PG8_SB(1, 0), b3, voffB); PG8_STAGE(PG8_SB(1, 1), b3 + hstepB, voffB); PG8_STAGE(PG8_SA(1, 0), a3, voffA);
            PG8_WAIT_V(8); PG8_WAIT_L(0); PG8_BAR; PG8_MMA(1, 0, At, B0); PG8_MMA(1, 1, At, B1); PG8_BAR; PG8_SCHED;
        }
        if (align) { if (wr == 0) PG8_BAR; }
        { const int lx = lane_id(); if (F8) E.gate(acc, cur, wr, wc, lx & 15, lx >> 4); else E(acc, cur, wr, wc, lx & 15, lx >> 4); }
        if (!has_next) break;
        if (!(E.mode == EM_PAB && cur.ph == 0)) {
#pragma unroll
        for (int a = 0; a < 2; ++a)
#pragma unroll
            for (int b = 0; b < 2; ++b)
#pragma unroll
                for (int m = 0; m < 4; ++m)
#pragma unroll
                    for (int n = 0; n < 2; ++n) acc[a][b][m][n] = (f32x4){0.f, 0.f, 0.f, 0.f};
        }
        cur = nxt; cA = nA; cB = nB; ++ui;
        if (align) { if (wr == 1) PG8_BAR; }
    }
    PG8_WAIT_V(0);
    if (!align) { if (wr == 0) PG8_BAR; }
    PG8_BAR;
#undef PG8_SA
#undef PG8_SB
#undef PG8_STAGE
#undef PG8_LDA
#undef PG8_LDB
#undef PG8_MMA
#undef PG8_WAIT_V
#undef PG8_WAIT_L
#undef PG8_BAR
#undef PG8_SCHED
}
}

#define XB_TMO      128
#define XB_XCNT(j)  (256  + 64 * (j))
#define XB_XSUB(j)  (1280 + 64 * (j))
#define XB_XGEN(j)  (2304 + 64 * (j))
#define XB_TOP      3328
#define XB_TOPGEN   3392
#define XCD_BAR_WORDS 3456
#define XB_SPIN_CAP (1u << 18)
__device__ __forceinline__ unsigned xb_ld(unsigned* p)              { return __hip_atomic_load(p, __ATOMIC_RELAXED, __HIP_MEMORY_SCOPE_AGENT); }
__device__ __forceinline__ unsigned xb_add(unsigned* p, unsigned v) { return __hip_atomic_fetch_add(p, v, __ATOMIC_RELAXED, __HIP_MEMORY_SCOPE_AGENT); }
__device__ __forceinline__ unsigned xb_xcc_id() { return (unsigned)__builtin_amdgcn_s_getreg((3 << 11) | 20) & 0xFu; }
#define XB_SPIN(cond, bar) do { unsigned _sp = 0; while (cond) { __builtin_amdgcn_s_sleep(1); \
    if ((++_sp & 255u) == 0u) { if (xb_ld(&(bar)[XB_TMO])) break; if (_sp > XB_SPIN_CAP) { atomicAdd(&(bar)[XB_TMO], 1u); break; } } } } while (0)
struct XcdBarrier { unsigned* bar; unsigned x; volatile LAS unsigned* st; };
__device__ __forceinline__ XcdBarrier xcd_barrier_post(unsigned* bar, volatile LAS unsigned* st, bool lead) {
    XcdBarrier b; b.bar = bar; b.x = xb_xcc_id(); b.st = st;
    if (lead) (void)xb_add(&bar[XB_XCNT(b.x)], 1u);
    return b;
}
__device__ __forceinline__ void xcd_barrier_complete(unsigned* bar, unsigned x, unsigned& nloc, unsigned& nx) {
    const unsigned G = gridDim.x * gridDim.y * gridDim.z;
    unsigned sum, cnt, mine, sp = 0u;
    for (;;) {
        sum = 0u; cnt = 0u; mine = 0u;
#pragma unroll
        for (unsigned j = 0; j < 16; ++j) { const unsigned c = xb_ld(&bar[XB_XCNT(j)]); sum += c; cnt += (c > 0u) ? 1u : 0u; mine = (j == x) ? c : mine; }
        if (sum == G) break;
        __builtin_amdgcn_s_sleep(1);
        if ((++sp & 255u) == 0u) { if (xb_ld(&bar[XB_TMO])) break; if (sp > XB_SPIN_CAP) { atomicAdd(&bar[XB_TMO], 1u); break; } }
    }
    nloc = mine > 0u ? mine : 1u; nx = cnt > 0u ? cnt : 1u;
}
__device__ __forceinline__ void xcd_barrier(const XcdBarrier& b, bool lead) {
    asm volatile("s_waitcnt vmcnt(0)" ::: "memory");
    __syncthreads();
    if (lead) {
        unsigned* bar = b.bar;
        __builtin_amdgcn_s_waitcnt(0);
        unsigned nloc = b.st[0], nx = b.st[1];
        if (nloc == 0u) { xcd_barrier_complete(bar, b.x, nloc, nx); b.st[0] = nloc; b.st[1] = nx; }
        const unsigned old = xb_add(&bar[XB_XSUB(b.x)], 1u);
        const unsigned gen = old / nloc;
        if (old + 1u == (gen + 1u) * nloc) {
            __builtin_amdgcn_fence(__ATOMIC_RELEASE, "agent");
            asm volatile("s_waitcnt vmcnt(0)" ::: "memory");
            const unsigned og = xb_add(&bar[XB_TOP], 1u);
            const unsigned tg = og / nx;
            if (og + 1u == (tg + 1u) * nx) xb_add(&bar[XB_TOPGEN], 1u);
            else XB_SPIN(xb_ld(&bar[XB_TOPGEN]) == tg, bar);
            __builtin_amdgcn_fence(__ATOMIC_ACQUIRE, "agent");
            xb_add(&bar[XB_XGEN(b.x)], 1u);
            asm volatile("s_waitcnt vmcnt(0)" ::: "memory");
        } else {
            XB_SPIN(xb_ld(&bar[XB_XGEN(b.x)]) == gen, bar);
            __builtin_amdgcn_fence(__ATOMIC_ACQUIRE, "agent");
            asm volatile("s_waitcnt vmcnt(0)" ::: "memory");
        }
    }
    __syncthreads();
}

struct Frame {
    LAS unsigned char* lds;
    int tid, lane, wave, G, bx;
    unsigned char* ws;
};

__device__ __forceinline__ void big_gemm(Frame& F, const Params& p, int mode, const void* A, int lda, const void* B, int ldb, int M, int N, int K) {
    pg8::Sched S; S.A = (const char*)A; S.B = (const char*)B; S.gA = 0; S.gB = 0; S.lda = lda; S.ldb = ldb; S.nM = M / 256; S.nN = N / 256; S.nG = 1; S.G = F.G; S.c = F.bx; S.A2 = S.A; S.B2 = S.B; S.pair = 0; S.esz = 2;
    pg8::Epi E; E.mode = mode; E.ws = F.ws; E.x = p.in[0]; E.out = p.out; E.modf = (const float*)(F.ws + WS_MODF);
    pg8::gemm_phase(F.lds, K, S, E, F.wave);
}

__device__ __forceinline__ void p0_transpose_item(const float* W, int K, int N, bf16* WT, LAS float* scr, int item, int lane, bool gatemix = false) {
    const int nblk = N / 32, kb = item / nblk, nb = item % nblk, k0 = 64 * kb, n0 = 32 * nb;
    int nd0 = n0;
    if (gatemix && n0 >= 3072) { const int a = (n0 - 3072) >> 11, d = (n0 - 3072) & 2047; nd0 = 3072 + (d >> 7) * 256 + a * 128 + (d & 127); }
#pragma unroll 8
    for (int i = 0; i < 32; ++i) { const int kk = 2 * i + (lane >> 5); scr[kk * 33 + (lane & 31)] = W[(size_t)(k0 + kk) * N + n0 + (lane & 31)]; }
    LDS_WAIT(); asm volatile("" ::: "memory");
    const int c = lane & 7;
#pragma unroll
    for (int j = 0; j < 4; ++j) { const int n = (lane >> 3) + 8 * j; const LAS float* s = scr + (8 * c) * 33 + n;
        if (gatemix && n0 >= 3072) {
            int w0 = __builtin_amdgcn_cvt_pk_fp8_f32(64.f * s[0 * 33], 64.f * s[1 * 33], 0, false); w0 = __builtin_amdgcn_cvt_pk_fp8_f32(64.f * s[2 * 33], 64.f * s[3 * 33], w0, true);
            int w1 = __builtin_amdgcn_cvt_pk_fp8_f32(64.f * s[4 * 33], 64.f * s[5 * 33], 0, false); w1 = __builtin_amdgcn_cvt_pk_fp8_f32(64.f * s[6 * 33], 64.f * s[7 * 33], w1, true);
            u32x2 o2; o2.x = (unsigned)w0; o2.y = (unsigned)w1;
            *(u32x2*)((unsigned char*)WT + (WS_WIN8 - WS_WIN) + (size_t)(nd0 - 3072 + n) * K + k0 + 8 * c) = o2;
            continue;
        }
        u32x4 o; o.x = pk2(s[0 * 33], s[1 * 33]); o.y = pk2(s[2 * 33], s[3 * 33]); o.z = pk2(s[4 * 33], s[5 * 33]); o.w = pk2(s[6 * 33], s[7 * 33]);
        *(u32x4*)(WT + (size_t)(nd0 + n) * K + k0 + 8 * c) = o; }
    LDS_WAIT(); asm volatile("" ::: "memory");
}

__device__ __forceinline__ void p0_mod_item(Frame& F, const Params& p, int item) {
    constexpr int KS = D / KSL;
    LAS float* sv = (LAS float*)F.lds;
    const int ks = item / 6, cb = item % 6, k0 = ks * KS;
    __syncthreads();
    for (int i = F.tid; i < 3 * KS; i += NTHREADS) { const int r = i / KS, k = i % KS; const float c = (r < 2) ? p.in[1][r * D + k0 + k] : p.in[3][k0 + k]; sv[i] = c / (1.f + __expf(-c)); }
    __syncthreads();
    const int col = cb * 2048 + F.tid * 4;
    const float* W = p.in[4] + (size_t)k0 * 12288 + col;
    f32x4 a0 = {0, 0, 0, 0}, a1 = a0, a2 = a0;
#pragma unroll 16
    for (int k = 0; k < KS; ++k) { const f32x4 w = *(const f32x4*)(W + (size_t)k * 12288); a0 += w * sv[k]; a1 += w * sv[KS + k]; a2 += w * sv[2 * KS + k]; }
    float* o = (float*)(F.ws + WS_MODP) + (size_t)ks * 3 * 12288 + col;
    *(f32x4*)o = a0; *(f32x4*)(o + 12288) = a1; *(f32x4*)(o + 2 * 12288) = a2;
}

__device__ __forceinline__ void p0_s5_tables(Frame& F, const Params& p, int g, int half) {
    typedef float f2 __attribute__((ext_vector_type(2)));
    LAS f2* pw = (LAS f2*)F.lds;
    LAS f2* Bb = (LAS f2*)(F.lds + 34560);
    LAS f2* Cc = (LAS f2*)(F.lds + 34560 + 16384);
    LAS float* Kt = (LAS float*)(F.lds + 34560 + 16384 + 16640);
    const float* a_re = p.in[8]; const float* a_im = p.in[9]; const float* log_dt = p.in[10];
    const float* b_re = p.in[11]; const float* b_im = p.in[12]; const float* c_re = p.in[13]; const float* c_im = p.in[14]; const float* dsk = p.in[15];
    __syncthreads();
    if (F.tid < 128) {
        const int d = F.tid >> 6, pp = F.tid & 63;
        const float lr = a_re[(d * 64 + g) * 64 + pp], li = a_im[(d * 64 + g) * 64 + pp], dt = __expf(log_dt[d * 64 + g]);
        {
            const float mag1 = expf(dt * lr); float sn1, cs1; sincosf(dt * li, &sn1, &cs1); const float ar = mag1 * cs1, ai = mag1 * sn1; float wr = 1.f, wi = 0.f;
            for (int tau = 0; tau <= 32; ++tau) { pw[(d * 33 + tau) * 65 + pp] = (f2){wr, wi}; const float nr = wr * ar - wi * ai; wi = wr * ai + wi * ar; wr = nr; }
        }
        const float x = dt * lr, y = dt * li; float sn, cs, sh, ch; sincosf(y, &sn, &cs); sincosf(0.5f * y, &sh, &ch);
        const float em = expm1f(x), nr = em * cs - 2.f * sh * sh, ni = (em + 1.f) * sn;
        const float den = lr * lr + li * li, qr = (nr * lr + ni * li) / den, qi = (ni * lr - nr * li) / den;
        for (int h = 0; h < 16; ++h) { const float br = b_re[((d * 64 + g) * 64 + pp) * 16 + h], bi = b_im[((d * 64 + g) * 64 + pp) * 16 + h]; Bb[(d * 64 + pp) * 16 + h] = (f2){qr * br - qi * bi, qr * bi + qi * br}; }
        for (int h = 0; h < 16; ++h) Cc[(d * 16 + h) * 65 + pp] = (f2){c_re[((d * 64 + g) * 16 + h) * 64 + pp], c_im[((d * 64 + g) * 16 + h) * 64 + pp]};
    }
    __syncthreads();
    {
        const int d = F.tid >> 8, tau = (F.tid >> 3) & 31, hp0 = (F.tid & 7) * 2;
        for (int hh = 0; hh < 2; ++hh) {
            const int hp = hp0 + hh; float accv[16];
#pragma unroll
            for (int h = 0; h < 16; ++h) accv[h] = 0.f;
            for (int pp = 0; pp < 64; ++pp) {
                const f2 c = Cc[(d * 16 + hp) * 65 + pp], w = pw[(d * 33 + tau) * 65 + pp]; const float wr = c.x * w.x - c.y * w.y, wi = c.x * w.y + c.y * w.x;
#pragma unroll
                for (int h = 0; h < 16; ++h) { const f2 b = Bb[(d * 64 + pp) * 16 + h]; accv[h] += wr * b.x - wi * b.y; }
            }
#pragma unroll
            for (int h = 0; h < 16; ++h) Kt[((d * 32 + tau) * 16 + hp) * 16 + h] = accv[h];
        }
    }
    __syncthreads();
    bf16* MF = (bf16*)(F.ws + WS_MFULL) + (size_t)g * 512 * XK;
    for (int c = half * 256 * 96 + F.tid; c < (half + 1) * 256 * 96; c += NTHREADS) {
        const int row = c / 96, kc = (c % 96) * 8, j = row >> 4, hp = row & 15; float v[8];
        if (kc < 512) {
            const int s = kc >> 4, h0 = kc & 15;
#pragma unroll
            for (int e = 0; e < 8; ++e) { const int h = h0 + e; float val;
                if (j > s) val = Kt[((0 * 32 + (j - s)) * 16 + hp) * 16 + h];
                else if (s > j) val = Kt[((1 * 32 + (s - j)) * 16 + hp) * 16 + h];
                else val = Kt[((0 * 32 + 0) * 16 + hp) * 16 + h] + Kt[((1 * 32 + 0) * 16 + hp) * 16 + h] + (h == hp ? dsk[g * 16 + h] : 0.f);
                v[e] = val; }
        } else {
            const int kk = kc - 512, blk = kk >> 6, p0 = kk & 63, d = blk >> 1, tau = d ? (32 - j) : (j + 1);
#pragma unroll
            for (int e = 0; e < 8; ++e) { const f2 c2 = Cc[(d * 16 + hp) * 65 + p0 + e], w = pw[(d * 33 + tau) * 65 + p0 + e];
                v[e] = (blk & 1) ? -(c2.x * w.y + c2.y * w.x) : (c2.x * w.x - c2.y * w.y); }
        }
        u32x4 o; o.x = pk2(v[0], v[1]); o.y = pk2(v[2], v[3]); o.z = pk2(v[4], v[5]); o.w = pk2(v[6], v[7]);
        *(u32x4*)(MF + (size_t)row * XK + kc) = o;
    }
    bf16* MS = (bf16*)(F.ws + WS_MS) + (size_t)g * 256 * 512;
    for (int c = half * 128 * 64 + F.tid; c < (half + 1) * 128 * 64; c += NTHREADS) {
        const int row = c >> 6, kc = (c & 63) * 8, s = kc >> 4, h0 = kc & 15, blk = row >> 6, pp = row & 63, d = blk >> 1, tau = d ? s : (31 - s);
        const f2 w = pw[(d * 33 + tau) * 65 + pp]; float v[8];
#pragma unroll
        for (int e = 0; e < 8; ++e) { const f2 b = Bb[(d * 64 + pp) * 16 + h0 + e]; v[e] = (blk & 1) ? (w.x * b.y + w.y * b.x) : (w.x * b.x - w.y * b.y); }
        u32x4 o; o.x = pk2(v[0], v[1]); o.y = pk2(v[2], v[3]); o.z = pk2(v[4], v[5]); o.w = pk2(v[6], v[7]);
        *(u32x4*)(MS + (size_t)row * 512 + kc) = o;
    }
    __syncthreads();
}

__device__ __forceinline__ void phase0a(Frame& F, const Params& p, const int parts = 7) {
    if (parts & 1) { if (F.bx < 6 * KSL) p0_mod_item(F, p, F.bx);
    else if (F.bx >= 128) p0_s5_tables(F, p, (F.bx - 128) >> 1, (F.bx - 128) & 1); }
    __syncthreads();
    LAS float* scr = (LAS float*)(F.lds + F.wave * 16384);
    const int gw = F.bx * NWAVES + F.wave, NGW = F.G * NWAVES;
    const bool freeb = (F.bx >= 6 * KSL) && (F.bx < 128);
    const int fw = (F.bx - 6 * KSL) * NWAVES + F.wave, NFW = (128 - 6 * KSL) * NWAVES;
    constexpr int I_IN = (D / 64) * (INW / 32), I_GLU = (S5W / 64) * (S5W / 32), I_PA = (S5W / 64) * (D / 32), I_PB = I_PA, I_OUT = (D / 64) * (D / 32), I_Q = I_OUT;
    constexpr int NT1 = I_IN + I_GLU, NT1F = (NT1 * 3 / 20 / 8) * 8;
    if (parts & 2) for (int stage = 0; stage < 2; ++stage) {
        if (stage == 0 && !freeb) continue;
        const int beg = stage == 0 ? fw : NT1F + gw, end = stage == 0 ? NT1F : NT1, step = stage == 0 ? NFW : NGW;
        for (int it = beg; it < end; it += step) {
            int r = it;
            if (r < I_IN) { p0_transpose_item(p.in[7], D, INW, (bf16*)(F.ws + WS_WIN), scr, r, F.lane, true); continue; }
            p0_transpose_item(p.in[16], S5W, S5W, (bf16*)(F.ws + WS_WGLU), scr, r - I_IN, F.lane);
        }
    }
    constexpr int NT2 = 2 * 16384, NT2F = (NT2 * 3 / 20 / 8) * 8;
    if (parts & 4) for (int stage = 0; stage < 2; ++stage) {
        if (stage == 0 && !freeb) continue;
        const int beg = stage == 0 ? fw : NT2F + gw, end = stage == 0 ? NT2F : NT2, step = stage == 0 ? NFW : NGW;
        for (int it = beg; it < end; it += step) {
            const int which = it >> 14, row = it & 16383;
            const f32x4* src = (const f32x4*)(p.in[30 + which] + (size_t)row * D) + F.lane;
            f32x4 v[8];
#pragma unroll
            for (int j = 0; j < 8; ++j) v[j] = src[64 * j];
            {
                float ssq = 0.f;
#pragma unroll
                for (int j = 0; j < 8; ++j) ssq += (v[j][0] * v[j][0] + v[j][1] * v[j][1]) + (v[j][2] * v[j][2] + v[j][3] * v[j][3]);
                ssq = wave_sum(ssq, F.lane);
                const float stepq = 0.3352f * sqrtf(ssq * (1.f / D)), invs = stepq > 0.f ? 1.f / stepq : 0.f;
                unsigned char* dst4 = F.ws + (which ? WS_PV : WS_PU);
                const int nadd = (F.lane & 1) ? 16 : 8;
#pragma unroll
                for (int j = 0; j < 8; ++j) {
                    unsigned nib = 0;
#pragma unroll
                    for (int i = 0; i < 4; ++i) { int q = (int)floorf(v[j][i] * invs); q = q < -8 ? -8 : (q > 7 ? 7 : q); nib |= (unsigned)((q + nadd) & 15) << (8 * i); }
                    const unsigned other = (unsigned)__builtin_amdgcn_update_dpp(0, (int)nib, 0xB1, 0xF, 0xF, false);
                    if (!(F.lane & 1)) *(unsigned*)(dst4 + ((size_t)j * 16384 + row) * 128 + (F.lane >> 1) * 4) = nib | (other << 4);
                }
                if (F.lane == 0) ((float*)(F.ws + (which ? WS_SV : WS_SU)))[row] = stepq;
            }
        }
    }
    const int gt = F.bx * NTHREADS + F.tid, NGT = F.G * NTHREADS;
    for (int i = gt; i < 2 * 128 * 128; i += NGT) ((bf16*)(F.ws + WS_SKB))[i] = (bf16)f2bf(p.in[29][i]);
    for (int i = gt; i < 2 * 16 * 2 * 64 * 64; i += NGT) {
        const int ii = i & 63, j = (i >> 6) & 63, gate = (i >> 12) & 1, h = (i >> 13) & 15, d = i >> 17;
        const float* w = gate ? p.in[22] : p.in[20];
        ((bf16*)(F.ws + WS_LW))[i] = (bf16)f2bf(-1.4426950408889634f * w[((size_t)(d * 16 + h) * 64 + ii) * 64 + j]);
    }
}

__device__ __forceinline__ void phase_norm(Frame& F, const Params& p, int which) {
    LAS float* gs = (LAS float*)F.lds;
    LAS float* sh = (LAS float*)(F.lds + 3 * D * 4);
    const float* modp = (const float*)(F.ws + WS_MODP); float* modf = (float*)(F.ws + WS_MODF);
    const float* bada = p.in[5];
    __syncthreads();
    if (which == 0) {
        for (int i = F.tid; i < 3 * D; i += NTHREADS) {
            const int r = i / D, k = i % D; float s0 = bada[k], s1 = bada[D + k];
            for (int ks = 0; ks < KSL; ++ks) { s0 += modp[(size_t)(ks * 3 + r) * 12288 + k]; s1 += modp[(size_t)(ks * 3 + r) * 12288 + D + k]; }
            gs[i] = p.in[6][k] * (1.f + s1); sh[i] = s0;
        }
        for (int i = F.bx * NTHREADS + F.tid; i < 3 * 12288; i += F.G * NTHREADS) {
            const int r = i / 12288, c = i % 12288; float s = bada[c];
            for (int ks = 0; ks < KSL; ++ks) s += modp[(size_t)(ks * 3 + r) * 12288 + c];
            modf[i] = s;
        }
    } else {
        for (int i = F.tid; i < 2 * D; i += NTHREADS) { const int r = i / D, k = i % D; gs[i] = p.in[27][k] * (1.f + modf[r * 12288 + 4 * D + k]); sh[i] = modf[r * 12288 + 3 * D + k]; }
    }
    __syncthreads();
    const int gw = F.bx * NWAVES + F.wave, NGW = F.G * NWAVES;
    const int nrows = which == 0 ? NTOK + NCTXT : NTOK;
    for (int m = gw; m < nrows; m += NGW) {
        const float* xrow; bf16* orow; int r;
        if (which == 0) {
            if (m < NTOK) { xrow = p.in[0] + (size_t)m * D; orow = (bf16*)(F.ws + WS_NBUF) + (size_t)m * D; r = m >> 14; }
            else { xrow = p.in[2] + (size_t)(m - NTOK) * D; orow = (bf16*)(F.ws + WS_NCTX) + (size_t)(m - NTOK) * D; r = 2; }
        } else { xrow = p.in[0] + (size_t)m * D; orow = (bf16*)(F.ws + WS_NBUF) + (size_t)m * D; r = m >> 14; }
        const f32x4* xr = (const f32x4*)xrow + F.lane;
        f32x4 v[8]; float s = 0.f;
        if (which == 1) {
            const u32x2* mr = (const u32x2*)((const bf16*)(F.ws + WS_MIX) + (size_t)m * D) + F.lane;
#pragma unroll
            for (int j = 0; j < 8; ++j) { const u32x2 mw = mr[64 * j]; v[j] = (f32x4){bf_lo(mw.x), bf_hi(mw.x), bf_lo(mw.y), bf_hi(mw.y)}; }
        } else {
#pragma unroll
            for (int j = 0; j < 8; ++j) v[j] = xr[64 * j];
        }
#pragma unroll
        for (int j = 0; j < 8; ++j) s += (v[j][0] * v[j][0] + v[j][1] * v[j][1]) + (v[j][2] * v[j][2] + v[j][3] * v[j][3]);
        const float rstd = rsqrtf(wave_sum(s, F.lane) * (1.f / D) + 1e-6f);
        u32x2* o8 = (u32x2*)orow + F.lane;
        float am = 0.f;
#pragma unroll
        for (int j = 0; j < 8; ++j) {
            const f32x4 g4 = *(const LAS f32x4*)(gs + r * D + 4 * F.lane + 256 * j), s4 = *(const LAS f32x4*)(sh + r * D + 4 * F.lane + 256 * j);
            v[j] = (f32x4){v[j][0] * rstd * g4[0] + s4[0], v[j][1] * rstd * g4[1] + s4[1], v[j][2] * rstd * g4[2] + s4[2], v[j][3] * rstd * g4[3] + s4[3]};
            u32x2 o; o.x = pk2(v[j][0], v[j][1]); o.y = pk2(v[j][2], v[j][3]);
            o8[64 * j] = o;
            if (which == 0 && m < NTOK) {
                int w8 = __builtin_amdgcn_cvt_pk_fp8_f32(v[j][0], v[j][1], 0, false); w8 = __builtin_amdgcn_cvt_pk_fp8_f32(v[j][2], v[j][3], w8, true);
                ((unsigned*)(F.ws + WS_NBUF8 + (size_t)m * D))[F.lane + 64 * j] = (unsigned)w8;
            }
            am = fmaxf(am, fmaxf(fmaxf(fabsf(v[j][0]), fabsf(v[j][1])), fmaxf(fabsf(v[j][2]), fabsf(v[j][3]))));
        }
        if (which == 1) {
#pragma unroll
            for (int o = 1; o < 64; o <<= 1) am = fmaxf(am, shx(am, o, F.lane));
            const float inv = am > 0.f ? 127.f / am : 0.f;
            unsigned* fq = (unsigned*)(F.ws + WS_FQ + (size_t)m * D) + F.lane;
            int qsum = 0;
#pragma unroll
            for (int j = 0; j < 8; ++j) {
                const int q0 = (int)rintf(v[j][0] * inv), q1 = (int)rintf(v[j][1] * inv), q2 = (int)rintf(v[j][2] * inv), q3 = (int)rintf(v[j][3] * inv);
                fq[64 * j] = (unsigned)(q0 & 255) | ((unsigned)(q1 & 255) << 8) | ((unsigned)(q2 & 255) << 16) | ((unsigned)(q3 & 255) << 24);
                qsum += (q0 + q1) + (q2 + q3);
            }
#pragma unroll
            for (int o = 2; o < 64; o <<= 1) qsum += shx(qsum, o, F.lane);
            if (F.lane == 0) ((float*)(F.ws + WS_FS))[m] = am * (1.f / 127.f);
            if (F.lane < 2) ((int*)(F.ws + WS_FS + (1u << 20)))[2 * m + F.lane] = qsum;
        }
    }
}

__device__ __forceinline__ void ctx_in_gemm(Frame& F) {
    const int w = F.bx * NWAVES + F.wave; if (w >= 2048) return;
    const int rt = w >> 6, ct = w & 63, l15 = F.lane & 15, q = F.lane >> 4;
    const bf16* A = (const bf16*)(F.ws + WS_NCTX) + (size_t)(rt * 16 + l15) * D + 8 * q;
    const bf16* B0 = (const bf16*)(F.ws + WS_WIN) + (size_t)(ct * 32 + l15) * D + 8 * q;
    const bf16* B1 = B0 + (size_t)16 * D;
    f32x4 a0 = {0, 0, 0, 0}, a1 = a0;
#pragma unroll 8
    for (int ks = 0; ks < 64; ++ks) {
        const bf16x8 a = *(const bf16x8*)(A + ks * 32), b0 = *(const bf16x8*)(B0 + ks * 32), b1 = *(const bf16x8*)(B1 + ks * 32);
        a0 = __builtin_amdgcn_mfma_f32_16x16x32_bf16(a, b0, a0, 0, 0, 0); a1 = __builtin_amdgcn_mfma_f32_16x16x32_bf16(a, b1, a1, 0, 0, 0);
    }
#pragma unroll
    for (int nn = 0; nn < 2; ++nn)
#pragma unroll
        for (int r = 0; r < 4; ++r) {
            const int tc = rt * 16 + 4 * q + r, c = ct * 32 + nn * 16 + l15; const float v = nn ? a1[r] : a0[r];
            if (c < 1024) ((bf16*)(F.ws + WS_XC))[((size_t)((c >> 4) * 16 + (tc >> 5)) * 512) + (tc & 31) * 16 + (c & 15)] = (bf16)f2bf(v);
            else ((bf16*)(F.ws + WS_VC))[(size_t)tc * LRUW + (c - 1024)] = (bf16)f2bf(v);
        }
}
__device__ __forceinline__ void ctx_s5_states(Frame& F) {
    const int w = F.bx * NWAVES + F.wave; if (w >= 1024) return;
    const int g = w >> 4, ctile = w & 15, l15 = F.lane & 15, q = F.lane >> 4;
    const bf16* A = (const bf16*)(F.ws + WS_XC) + (size_t)(g * 16 + l15) * 512 + 8 * q;
    const bf16* B = (const bf16*)(F.ws + WS_MS) + (size_t)(g * 256 + ctile * 16 + l15) * 512 + 8 * q;
    f32x4 a0 = {0, 0, 0, 0};
#pragma unroll
    for (int ks = 0; ks < 16; ++ks) a0 = __builtin_amdgcn_mfma_f32_16x16x32_bf16(*(const bf16x8*)(A + ks * 32), *(const bf16x8*)(B + ks * 32), a0, 0, 0, 0);
#pragma unroll
    for (int r = 0; r < 4; ++r) ((float*)(F.ws + WS_SC))[(size_t)(g * 16 + 4 * q + r) * 256 + ctile * 16 + l15] = a0[r];
}

constexpr int LRU_WROW = 72;
__device__ __forceinline__ float fast_sigmoid(float x) { return __builtin_amdgcn_rcpf(1.f + __expf(-x)); }
template <int PASS>
__device__ __forceinline__ void lru_item(Frame& F, const LAS bf16* lw, const LAS float* prm, const LAS float* cwl, LAS float* xs, int head, int item) {
    const int rc = item & 7, col = (item >> 3) % 65, b = (item >> 3) / 65;
    int lane = F.lane; asm volatile("" : "+v"(lane));
    const int t = lane & 31, hh = lane >> 5;
    const bf16* vbase; size_t rstride;
    if (col < 64) { vbase = (const bf16*)(F.ws + WS_V) + ((size_t)(b * SEQ + col) * LRUW + head * 64); rstride = (size_t)64 * LRUW; }
    else { vbase = (const bf16*)(F.ws + WS_VC) + ((size_t)(b * CTXL) * LRUW + head * 64); rstride = LRUW; }
    const int r0 = rc * 32, r = r0 + t;
    const int q = (col < 64) ? (8 + col * 8 + rc) : rc;
    u32x4 vw[4][4];
#pragma unroll
    for (int k = 0; k < 4; ++k) {
        const int rr = r - 1 + k; const bool ok = (rr >= 0) && (rr < 256);
        const bf16* vr = vbase + (size_t)(ok ? rr : r) * rstride;
#pragma unroll
        for (int ks = 0; ks < 4; ++ks) { u32x4 w = *(const u32x4*)(vr + 16 * ks + 8 * hh); if (!ok) w = (u32x4){0u, 0u, 0u, 0u}; vw[k][ks] = w; }
    }
    float lc[2][2]; u32x4 gq[4];
    const size_t tok = (size_t)b * SEQ + (size_t)r * 64 + col;
    if (PASS == 2) {
#pragma unroll
        for (int d = 0; d < 2; ++d)
#pragma unroll
            for (int ct = 0; ct < 2; ++ct) lc[d][ct] = ((const float*)(F.ws + WS_LC))[(size_t)((b * 2 + d) * NQ + q) * 1024 + head * 64 + t + 32 * ct];
    }
    float xa[4][8];
#pragma unroll
    for (int ks = 0; ks < 4; ++ks) {
        const int ch = 16 * ks + 8 * hh;
        const f32x4 b0 = *(const LAS f32x4*)(cwl + 4 * 64 + ch), b1 = *(const LAS f32x4*)(cwl + 4 * 64 + ch + 4);
#pragma unroll
        for (int j = 0; j < 4; ++j) { xa[ks][j] = b0[j]; xa[ks][4 + j] = b1[j]; }
    }
#pragma unroll
    for (int k = 0; k < 4; ++k)
#pragma unroll
        for (int ks = 0; ks < 4; ++ks) {
            const u32x4 w = vw[k][ks]; const int ch = 16 * ks + 8 * hh;
            const f32x4 c0 = *(const LAS f32x4*)(cwl + k * 64 + ch), c1 = *(const LAS f32x4*)(cwl + k * 64 + ch + 4);
            xa[ks][0] += c0[0] * bf_lo(w.x); xa[ks][1] += c0[1] * bf_hi(w.x); xa[ks][2] += c0[2] * bf_lo(w.y); xa[ks][3] += c0[3] * bf_hi(w.y);
            xa[ks][4] += c1[0] * bf_lo(w.z); xa[ks][5] += c1[1] * bf_hi(w.z); xa[ks][6] += c1[2] * bf_lo(w.w); xa[ks][7] += c1[3] * bf_hi(w.w);
        }
    bf16x8 af[4];
#pragma unroll
    for (int ks = 0; ks < 4; ++ks) {
        u32x4 w; w.x = cvt_pk_bf16(xa[ks][0], xa[ks][1]); w.y = cvt_pk_bf16(xa[ks][2], xa[ks][3]); w.z = cvt_pk_bf16(xa[ks][4], xa[ks][5]); w.w = cvt_pk_bf16(xa[ks][6], xa[ks][7]);
        af[ks] = __builtin_bit_cast(bf16x8, w);
        *(LAS f32x4*)(xs + t * 68 + 16 * ks + 8 * hh) = (f32x4){xa[ks][0], xa[ks][1], xa[ks][2], xa[ks][3]};
        *(LAS f32x4*)(xs + t * 68 + 16 * ks + 8 * hh + 4) = (f32x4){xa[ks][4], xa[ks][5], xa[ks][6], xa[ks][7]};
    }
    if (PASS == 2) {
#pragma unroll
        for (int ks = 0; ks < 4; ++ks) gq[ks] = *(const u32x4*)((const bf16*)(F.ws + WS_GG) + tok * LRUW + head * 64 + 16 * ks + 8 * hh);
    }
    LDS_WAIT(); asm volatile("" ::: "memory");
    float xd[2][16];
#pragma unroll
    for (int ct = 0; ct < 2; ++ct)
#pragma unroll
        for (int rg = 0; rg < 16; ++rg) xd[ct][rg] = xs[((rg & 3) + 8 * (rg >> 2) + 4 * hh) * 68 + t + 32 * ct];
    float ysum[2][16];
#pragma unroll
    for (int d = 0; d < 2; ++d) {
#pragma unroll
        for (int ct = 0; ct < 2; ++ct) {
            f32x16 acc[2];
#pragma unroll
            for (int gt = 0; gt < 2; ++gt) {
                f32x16 a; for (int i = 0; i < 16; ++i) a[i] = 0.f;
                const LAS bf16* wb = lw + ((d * 2 + gt) * 64 + t + 32 * ct) * LRU_WROW + 8 * hh;
#pragma unroll
                for (int ks = 0; ks < 4; ++ks) a = __builtin_amdgcn_mfma_f32_32x32x16_bf16(af[ks], *(const LAS bf16x8*)(wb + 16 * ks), a, 0, 0, 0);
                acc[gt] = a;
            }
            const int chl = t + 32 * ct, ch = head * 64 + chl;
            float av[16], bv[16];
            {
                const float br = prm[(d * 3 + 0) * 64 + chl], bi = prm[(d * 3 + 1) * 64 + chl], c8 = prm[(d * 3 + 2) * 64 + chl];
#pragma unroll
                for (int rg = 0; rg < 16; ++rg) {
                    const float rr = __builtin_amdgcn_rcpf(1.f + __builtin_amdgcn_exp2f(acc[0][rg] + br)), ii = __builtin_amdgcn_rcpf(1.f + __builtin_amdgcn_exp2f(acc[1][rg] + bi));
                    const float a = __builtin_amdgcn_exp2f(c8 * rr), om = fmaf(-a, a, 1.f);
                    av[rg] = a; bv[rg] = __builtin_amdgcn_sqrtf(fmaxf(om, 0.f)) * (ii * xd[ct][rg]);
                }
            }
            float hl[16], cp[16], sA[4], sB[4];
#pragma unroll
            for (int q4 = 0; q4 < 4; ++q4) {
                if (d == 0) {
                    hl[4 * q4] = bv[4 * q4]; cp[4 * q4] = av[4 * q4];
#pragma unroll
                    for (int i = 1; i < 4; ++i) { hl[4 * q4 + i] = av[4 * q4 + i] * hl[4 * q4 + i - 1] + bv[4 * q4 + i]; cp[4 * q4 + i] = av[4 * q4 + i] * cp[4 * q4 + i - 1]; }
                    sA[q4] = cp[4 * q4 + 3]; sB[q4] = hl[4 * q4 + 3];
                } else {
                    hl[4 * q4 + 3] = bv[4 * q4 + 3]; cp[4 * q4 + 3] = av[4 * q4 + 3];
#pragma unroll
                    for (int i = 2; i >= 0; --i) { hl[4 * q4 + i] = av[4 * q4 + i] * hl[4 * q4 + i + 1] + bv[4 * q4 + i]; cp[4 * q4 + i] = av[4 * q4 + i] * cp[4 * q4 + i + 1]; }
                    sA[q4] = cp[4 * q4]; sB[q4] = hl[4 * q4];
                }
            }
            float Ae[4], Be[4], Ao[4], Bo[4];
#pragma unroll
            for (int q4 = 0; q4 < 4; ++q4) {
                const float oA = shx(sA[q4], 32, lane), oB = shx(sB[q4], 32, lane);
                Ae[q4] = hh ? oA : sA[q4]; Be[q4] = hh ? oB : sB[q4]; Ao[q4] = hh ? sA[q4] : oA; Bo[q4] = hh ? sB[q4] : oB;
            }
            if (PASS == 1) {
                float c = 0.f, P = 1.f;
                if (d == 0) {
#pragma unroll
                    for (int q4 = 0; q4 < 4; ++q4) { c = Ae[q4] * c + Be[q4]; c = Ao[q4] * c + Bo[q4]; P *= Ae[q4] * Ao[q4]; } }
                else {
#pragma unroll
                    for (int q4 = 3; q4 >= 0; --q4) { c = Ao[q4] * c + Bo[q4]; c = Ae[q4] * c + Be[q4]; P *= Ae[q4] * Ao[q4]; } }
                if (hh == 0) { float* o = (float*)(F.ws + WS_PL) + ((size_t)((b * 2 + d) * NQ + q) * 1024 + ch) * 2; o[0] = P; o[1] = c; }
            } else {
                float cin[4];
                float c = lc[d][ct];
                if (d == 0) {
#pragma unroll
                    for (int q4 = 0; q4 < 4; ++q4) { const float c0 = c; c = Ae[q4] * c + Be[q4]; const float c1 = c; c = Ao[q4] * c + Bo[q4]; cin[q4] = hh ? c1 : c0; } }
                else {
#pragma unroll
                    for (int q4 = 3; q4 >= 0; --q4) { const float c0 = c; c = Ao[q4] * c + Bo[q4]; const float c1 = c; c = Ae[q4] * c + Be[q4]; cin[q4] = hh ? c0 : c1; } }
#pragma unroll
                for (int rg = 0; rg < 16; ++rg) { const float hv = hl[rg] + cp[rg] * cin[rg >> 2]; if (d == 0) ysum[ct][rg] = hv; else ysum[ct][rg] += hv; }
            }
        }
    }
    if (PASS == 2) {
#pragma unroll
        for (int ct = 0; ct < 2; ++ct)
#pragma unroll
            for (int rg = 0; rg < 16; ++rg) xs[((rg & 3) + 8 * (rg >> 2) + 4 * hh) * 68 + t + 32 * ct] = ysum[ct][rg];
        LDS_WAIT(); asm volatile("" ::: "memory");
        bf16* yb = (bf16*)(F.ws + WS_YB) + tok * LRUW + head * 64;
#pragma unroll
        for (int ks = 0; ks < 4; ++ks) {
            const int c0 = 16 * ks + 8 * hh; const u32x4 g4 = gq[ks];
            const f32x4 y0 = *(const LAS f32x4*)(xs + t * 68 + c0), y1 = *(const LAS f32x4*)(xs + t * 68 + c0 + 4);
            u32x4 o; o.x = cvt_pk_bf16(y0[0] * bf_lo(g4.x), y0[1] * bf_hi(g4.x)); o.y = cvt_pk_bf16(y0[2] * bf_lo(g4.y), y0[3] * bf_hi(g4.y));
            o.z = cvt_pk_bf16(y1[0] * bf_lo(g4.z), y1[1] * bf_hi(g4.z)); o.w = cvt_pk_bf16(y1[2] * bf_lo(g4.w), y1[3] * bf_hi(g4.w));
            *(u32x4*)(yb + c0) = o;
        }
    }
    LDS_WAIT(); asm volatile("" ::: "memory");
}

template <int PASS>
__device__ __forceinline__ void lru_phase(Frame& F, const Params& p) {
    LAS bf16* lw = (LAS bf16*)F.lds;
    LAS float* prm = (LAS float*)(F.lds + 36864);
    LAS float* cwl = (LAS float*)(F.lds + 36864 + 1536);
    LAS float* xs = (LAS float*)(F.lds + 40960 + F.wave * (32 * 68 * 4));
    const int head = F.bx & 15;
    __syncthreads();
    for (int i = F.tid; i < 4 * 64 * 8; i += NTHREADS) {
        const int c = i & 7, j = (i >> 3) & 63, m = i >> 9, d = m >> 1, gt = m & 1;
        const u32x4 w = *(const u32x4*)((const bf16*)(F.ws + WS_LW) + ((size_t)(((d * 16 + head) * 2 + gt) * 64 + j) * 64 + 8 * c));
        *(LAS u32x4*)(lw + (m * 64 + j) * LRU_WROW + 8 * c) = w;
    }
    for (int i = F.tid; i < 2 * 64; i += NTHREADS) {
        const int d = i >> 6, c = i & 63, ch = head * 64 + c; const float lam = p.in[19][d * LRUW + ch];
        prm[(d * 3 + 0) * 64 + c] = -1.4426950408889634f * p.in[21][d * LRUW + ch]; prm[(d * 3 + 1) * 64 + c] = -1.4426950408889634f * p.in[23][d * LRUW + ch];
        prm[(d * 3 + 2) * 64 + c] = 1.4426950408889634f * -8.f * (lam > 15.f ? __expf(-lam) : log1pf(__expf(-lam)));
    }
    for (int i = F.tid; i < 5 * 64; i += NTHREADS) { const int k = i >> 6, c = i & 63; cwl[i] = (k < 4) ? p.in[17][k * LRUW + head * 64 + c] : p.in[18][head * 64 + c]; }
    __syncthreads();
    const int wg = (F.bx >> 4) * NWAVES + F.wave, NWG = (F.G >> 4) * NWAVES;
    const int nitems = 2 * 65 * 8;
    for (int it = wg; it < nitems; it += NWG) {
        if (PASS == 2 && ((it >> 3) % 65) == 64) continue;
        lru_item<PASS>(F, lw, prm, cwl, xs, head, it);
    }
    __syncthreads();
}

__device__ __forceinline__ void phase_carry(Frame& F, const Params& p) {
    if (F.bx < 32) {
        const int id = F.bx * NTHREADS + F.tid, pp = id & 63, d = (id >> 6) & 1, g = (id >> 7) & 63, b = id >> 13;
        const float lr = p.in[8][(d * 64 + g) * 64 + pp], li = p.in[9][(d * 64 + g) * 64 + pp], dt = __expf(p.in[10][d * 64 + g]);
        const float mag = expf(32.f * dt * lr); float sn, cs; sincosf(32.f * dt * li, &sn, &cs); const float ar = mag * cs, ai = mag * sn;
        const float* SC = (const float*)(F.ws + WS_SC) + (size_t)(g * 16 + b * 8) * 256 + d * 128 + pp;
        const float* SB = (const float*)(F.ws + WS_SBUF) + (size_t)(g * NCHUNK + b * 512) * 256 + d * 128 + pp;
        bf16* X = (bf16*)(F.ws + WS_X) + (size_t)(g * NCHUNK + b * 512) * XK + 512 + d * 128 + pp;
        float hr = 0.f, hi = 0.f;
        if (d == 0) {
            for (int c = 0; c < 8; ++c) { const float sr = SC[c * 256], si = SC[c * 256 + 64]; const float nr = ar * hr - ai * hi + sr; hi = ar * hi + ai * hr + si; hr = nr; }
            for (int n0 = 0; n0 < 512; n0 += 8) {
                float sr[8], si[8];
#pragma unroll
                for (int u = 0; u < 8; ++u) { sr[u] = SB[(size_t)(n0 + u) * 256]; si[u] = SB[(size_t)(n0 + u) * 256 + 64]; }
#pragma unroll
                for (int u = 0; u < 8; ++u) { X[(size_t)(n0 + u) * XK] = (bf16)f2bf(hr); X[(size_t)(n0 + u) * XK + 64] = (bf16)f2bf(hi);
                    const float nr = ar * hr - ai * hi + sr[u]; hi = ar * hi + ai * hr + si[u]; hr = nr; }
            }
        } else {
            for (int c = 7; c >= 0; --c) { const float sr = SC[c * 256], si = SC[c * 256 + 64]; const float nr = ar * hr - ai * hi + sr; hi = ar * hi + ai * hr + si; hr = nr; }
            for (int n0 = 504; n0 >= 0; n0 -= 8) {
                float sr[8], si[8];
#pragma unroll
                for (int u = 0; u < 8; ++u) { sr[u] = SB[(size_t)(n0 + u) * 256]; si[u] = SB[(size_t)(n0 + u) * 256 + 64]; }
#pragma unroll
                for (int u = 7; u >= 0; --u) { X[(size_t)(n0 + u) * XK] = (bf16)f2bf(hr); X[(size_t)(n0 + u) * XK + 64] = (bf16)f2bf(hi);
                    const float nr = ar * hr - ai * hi + sr[u]; hi = ar * hi + ai * hr + si[u]; hr = nr; }
            }
        }
    } else if (F.bx < 40) {
        const int id = (F.bx - 32) * NTHREADS + F.tid, ch = id & 1023, d = (id >> 10) & 1, b = id >> 11;
        const float* PL = (const float*)(F.ws + WS_PL) + ((size_t)(b * 2 + d) * NQ * 1024 + ch) * 2;
        float* LC = (float*)(F.ws + WS_LC) + (size_t)(b * 2 + d) * NQ * 1024 + ch;
        float h = 0.f;
        if (d == 0) {
            for (int q = 0; q < 8; ++q) { h = PL[(size_t)q * 2048] * h + PL[(size_t)q * 2048 + 1]; }
            for (int q0 = 8; q0 < NQ; q0 += 8) {
                float P[8], L[8];
#pragma unroll
                for (int u = 0; u < 8; ++u) { P[u] = PL[(size_t)(q0 + u) * 2048]; L[u] = PL[(size_t)(q0 + u) * 2048 + 1]; }
#pragma unroll
                for (int u = 0; u < 8; ++u) { LC[(size_t)(q0 + u) * 1024] = h; h = P[u] * h + L[u]; }
            }
        } else {
            for (int q = 7; q >= 0; --q) { h = PL[(size_t)q * 2048] * h + PL[(size_t)q * 2048 + 1]; }
            for (int q0 = NQ - 8; q0 >= 8; q0 -= 8) {
                float P[8], L[8];
#pragma unroll
                for (int u = 0; u < 8; ++u) { P[u] = PL[(size_t)(q0 + u) * 2048]; L[u] = PL[(size_t)(q0 + u) * 2048 + 1]; }
#pragma unroll
                for (int u = 7; u >= 0; --u) { LC[(size_t)(q0 + u) * 1024] = h; h = P[u] * h + L[u]; }
            }
        }
    } else {
        LAS float* scr = (LAS float*)(F.lds + F.wave * 16384);
        constexpr int I_PA = (S5W / 64) * (D / 32), I_PB = I_PA, I_OUT = (D / 64) * (D / 32), I_Q = I_OUT;
        for (int it = (F.bx - 40) * NWAVES + F.wave; it < I_PA + I_PB + I_OUT + I_Q; it += (F.G - 40) * NWAVES) {
            int r = it;
            if (r < I_PA) { p0_transpose_item(p.in[24], S5W, D, (bf16*)(F.ws + WS_WPA), scr, r, F.lane); continue; } r -= I_PA;
            if (r < I_PB) { p0_transpose_item(p.in[25], LRUW, D, (bf16*)(F.ws + WS_WPB), scr, r, F.lane); continue; } r -= I_PB;
            if (r < I_OUT) { p0_transpose_item(p.in[26], D, D, (bf16*)(F.ws + WS_WOUT), scr, r, F.lane); continue; } r -= I_OUT;
            p0_transpose_item(p.in[28], D, D, (bf16*)(F.ws + WS_WQ), scr, r, F.lane);
        }
    }
}

constexpr unsigned char c_cand[50] = {
    0x00,0x01,0x02,0x03,0x04,0x05,0x06,0x07,0x08,0x09,0x0a,0x0b,0x0c,0x0d,0x0e,0x0f, 0x10,0x11,0x12,0x13,0x14,0x15,0x16,0x17, 0x20,
    0x21,0x22,0x23,0x24, 0x30,0x31,0x32,0x33, 0x40,0x41,0x42, 0x50,0x51, 0x60,0x61, 0x70,0x71, 0x80,0x90,0xa0,0xb0,0xc0,0xd0,0xe0,0xf0 };

__device__ __forceinline__ float umax_f(float a, float b) { return fmaxf(a, b); }

__device__ __forceinline__ float vmaxf(float a, float b) { float r; asm("v_max_f32 %0, %1, %2" : "=v"(r) : "v"(a), "v"(b)); return r; }
__device__ __forceinline__ float vminf(float a, float b) { float r; asm("v_min_f32 %0, %1, %2" : "=v"(r) : "v"(a), "v"(b)); return r; }
__device__ __forceinline__ void ce_desc(float& a, float& b) { const float hi = vmaxf(a, b), lo = vminf(a, b); a = hi; b = lo; }
constexpr unsigned char c_sort16[60] = {
    0x0d,0x1c,0x2f,0x3e,0x48,0x56,0x7b,0x9a, 0x05,0x17,0x29,0x34,0x6d,0x8e,0xaf,0xbc, 0x01,0x23,0x45,0x68,0x79,0xab,0xcd,0xef, 0x02,0x13,0x4a,0x5b,0x67,0x89,0xce,0xdf,
    0x12,0x3c,0x46,0x57,0x8a,0x9b,0xde, 0x14,0x26,0x58,0x7a,0x9d,0xbe, 0x24,0x36,0x9c,0xbd, 0x35,0x68,0x79,0xac, 0x34,0x56,0x78,0x9a,0xbc, 0x67,0x89 };
__device__ __forceinline__ void sort16_desc(float (&a)[16]) {
#pragma unroll
    for (int n = 0; n < 60; ++n) ce_desc(a[c_sort16[n] >> 4], a[c_sort16[n] & 15]);
}
__device__ __forceinline__ void merge_top16(float (&a)[16], const float (&b)[16]) {
#pragma unroll
    for (int i = 0; i < 16; ++i) a[i] = vmaxf(a[i], b[15 - i]);
#pragma unroll
    for (int j = 8; j > 0; j >>= 1)
#pragma unroll
        for (int i = 0; i < 16; ++i) { const int l = i ^ j; if (l > i) ce_desc(a[i], a[l]); }
}


__device__ __forceinline__ void peer_phase(Frame& F, const Params& p, const int parts = 7) {
    LAS int* sel_e = (LAS int*)F.lds; LAS float* sel_g = (LAS float*)(F.lds + 16640);
    LAS unsigned* tk = (LAS unsigned*)(F.lds + 33280);
    LAS unsigned char* skl = F.lds + 67072;
    const bf16* Q = (const bf16*)(F.ws + WS_Q); const bf16* SK = (const bf16*)(F.ws + WS_SKB);
    const bf16* FB = (const bf16*)(F.ws + WS_NBUF); const unsigned char* PU = F.ws + WS_PU; const unsigned char* PV = F.ws + WS_PV;
    const float* SU = (const float*)(F.ws + WS_SU); const float* SV = (const float*)(F.ws + WS_SV);
    const float* modf = (const float*)(F.ws + WS_MODF);
    const int lane = F.lane, t = lane & 31, hh = lane >> 5, head = F.wave;
    const unsigned NEG = 0xff800000u;
    __syncthreads();
    for (int i = F.tid; i < 256 * 16; i += NTHREADS) *(LAS u32x4*)(skl + (i >> 4) * 272 + (i & 15) * 16) = *(const u32x4*)(SK + (size_t)(i >> 4) * 128 + (i & 15) * 8);
    bf16x8 qf[8];
    if (F.bx < NTOK / 32) {
        const bf16* qp = Q + (size_t)(F.bx * 32 + t) * D + head * 256 + 8 * hh;
#pragma unroll
        for (int ks = 0; ks < 8; ++ks) qf[ks] = *(const bf16x8*)(qp + 16 * ks);
    }
    for (int tile = F.bx; tile < NTOK / 32; tile += F.G) {
        const int tok0 = tile * 32;
        __syncthreads();
        if (parts & 1) {
        LAS unsigned* mytk = tk + (size_t)(t * 8 + head) * 33;
#pragma unroll 1
        for (int side = 0; side < 2; ++side) {
            unsigned pk[64];
            {
                f32x16 acc[4];
#pragma unroll
                for (int kb = 0; kb < 4; ++kb) for (int i = 0; i < 16; ++i) acc[kb][i] = 0.f;
                const LAS unsigned char* sp = skl + (side * 128 + t) * 272 + 16 * hh;
#pragma unroll
                for (int ks = 0; ks < 8; ++ks) {
#pragma unroll
                    for (int kb = 0; kb < 4; ++kb) {
                        const bf16x8 sf = *(const LAS bf16x8*)(sp + kb * (32 * 272) + 32 * ks);
                        acc[kb] = __builtin_amdgcn_mfma_f32_32x32x16_bf16(sf, qf[ks], acc[kb], 0, 0, 0);
                    }
                }
                {
                    const int ntile = side ? tile + F.G : tile;
                    if (ntile < NTOK / 32) {
                        const bf16* qn = Q + (size_t)(ntile * 32 + t) * D + head * 256 + (side ^ 1) * 128 + 8 * hh;
#pragma unroll
                        for (int ks = 0; ks < 8; ++ks) qf[ks] = *(const bf16x8*)(qn + 16 * ks);
                    }
                }
#pragma unroll
                for (int kb = 0; kb < 4; ++kb)
#pragma unroll
                    for (int rg = 0; rg < 16; ++rg) pk[kb * 16 + rg] = (__float_as_uint(acc[kb][rg]) & ~0x7fu) | (unsigned)(kb * 32 + (rg & 3) + 8 * (rg >> 2) + 4 * hh);
            }
            {
                float g0[16], g1[16];
#pragma unroll
                for (int i = 0; i < 16; ++i) { g0[i] = __uint_as_float(pk[i]); g1[i] = __uint_as_float(pk[16 + i]); }
                sort16_desc(g0); sort16_desc(g1); merge_top16(g0, g1);
#pragma unroll
                for (int i = 0; i < 16; ++i) g1[i] = __uint_as_float(pk[32 + i]);
                sort16_desc(g1); merge_top16(g0, g1);
#pragma unroll
                for (int i = 0; i < 16; ++i) g1[i] = __uint_as_float(pk[48 + i]);
                sort16_desc(g1); merge_top16(g0, g1);
#pragma unroll
                for (int i = 0; i < 16; ++i) g1[i] = shx(g0[i], 32, lane);
                merge_top16(g0, g1);
                if (hh == 0) {
#pragma unroll
                    for (int i = 0; i < 16; ++i) mytk[side * 16 + i] = __float_as_uint(g0[i]);
                }
            }
        }
        LDS_WAIT(); asm volatile("" ::: "memory");
        {
            unsigned cd[25];
            {
                unsigned w0[16], w1[16];
#pragma unroll
                for (int i = 0; i < 16; ++i) { w0[i] = mytk[i]; w1[i] = mytk[16 + i]; }
#pragma unroll
                for (int n = 0; n < 25; ++n) {
                    const int idA = c_cand[n], idB = c_cand[25 + n];
                    const float vA = __uint_as_float(w0[idA >> 4] & ~0x7fu) + __uint_as_float(w1[idA & 15] & ~0x7fu);
                    const float vB = __uint_as_float(w0[idB >> 4] & ~0x7fu) + __uint_as_float(w1[idB & 15] & ~0x7fu);
                    cd[n] = hh ? ((__float_as_uint(vB) & ~0xffu) | (unsigned)idB) : ((__float_as_uint(vA) & ~0xffu) | (unsigned)idA);
                }
            }
            float c0[16], c1[16];
#pragma unroll
            for (int i = 0; i < 16; ++i) { c0[i] = __uint_as_float(cd[i]); c1[i] = (i < 9) ? __uint_as_float(cd[16 + i]) : __uint_as_float(NEG); }
            sort16_desc(c0); sort16_desc(c1); merge_top16(c0, c1);
#pragma unroll
            for (int i = 0; i < 16; ++i) c1[i] = shx(c0[i], 32, lane);
            merge_top16(c0, c1);
            float sc[16]; int ex[16];
#pragma unroll
            for (int rd = 0; rd < 16; ++rd) {
                const unsigned mb = __float_as_uint(c0[rd]);
                const unsigned w0 = mytk[(mb >> 4) & 15], w1 = mytk[16 + (mb & 15)];
                sc[rd] = __uint_as_float(w0 & ~0x7fu) + __uint_as_float(w1 & ~0x7fu);
                ex[rd] = (int)((w0 & 0x7fu) * 128u + (w1 & 0x7fu));
            }
            float mx = sc[0];
#pragma unroll
            for (int i = 1; i < 16; ++i) mx = fmaxf(mx, sc[i]);
            float sum = 0.f;
#pragma unroll
            for (int i = 0; i < 16; ++i) { sc[i] = __expf(sc[i] - mx); sum += sc[i]; }
            const float inv = 1.f / sum;
            if (hh == 0) {
#pragma unroll
                for (int i = 0; i < 16; ++i) { sel_e[t * 129 + head * 16 + i] = ex[i]; sel_g[t * 129 + head * 16 + i] = sc[i] * inv * SV[ex[i]]; }
            }
        }
        }
        __syncthreads();
        if (parts & 2) for (int i = F.tid; i < 32 * 128; i += NTHREADS) {
            const size_t gi = (size_t)tok0 * 128 + i;
            const int pp = i & 127, li = (i >> 7) * 129 + pp; ((int*)(F.ws + WS_SELE))[gi - pp + (pp & 7) * 16 + (pp >> 3)] = sel_e[li]; ((float*)(F.ws + WS_SELG))[gi] = sel_g[li]; ((float*)(F.ws + WS_SELU))[gi] = SU[sel_e[li]];
        }
    }
}

struct PeerVisit { u32x4 e[4]; u32x4 x, x2; float sc; int cs; };
template <bool VPASS>
__device__ __forceinline__ PeerVisit visit_load(const unsigned char* ws, const unsigned char* FQc, int tok, int lane) {
    PeerVisit v; const int pg = lane >> 3;
    const u32x4* ep = (const u32x4*)((const int*)(ws + WS_SELE) + (size_t)tok * 128 + pg * 16);
#pragma unroll
    for (int q = 0; q < 4; ++q) v.e[q] = ep[q];
    if (VPASS) { v.x = *(const u32x4*)(ws + WS_CFQ + (size_t)tok * 128 + pg * 16); v.x2 = v.x; v.sc = ((const float*)(ws + WS_CS))[2 * tok]; v.cs = ((const int*)(ws + WS_CS))[2 * tok + 1]; }
    else { const u32x4* fp = (const u32x4*)(FQc + (size_t)tok * D + (lane & 7) * 32); v.x = fp[0]; v.x2 = fp[1]; v.sc = 0.f; v.cs = 0; }
    return v;
}
__device__ __forceinline__ void rows16_load(u32x4 (&w)[16], const unsigned char* T, const PeerVisit& v, int lane) {
    const int pc = (lane & 7) * 16;
#pragma unroll
    for (int q = 0; q < 4; ++q) {
        w[4 * q + 0] = *(const u32x4*)(T + (v.e[q].x * 128u + (unsigned)pc)); w[4 * q + 1] = *(const u32x4*)(T + (v.e[q].y * 128u + (unsigned)pc));
        w[4 * q + 2] = *(const u32x4*)(T + (v.e[q].z * 128u + (unsigned)pc)); w[4 * q + 3] = *(const u32x4*)(T + (v.e[q].w * 128u + (unsigned)pc));
    }
}
__device__ __forceinline__ int dpp_add8(int v) {
    v += __builtin_amdgcn_update_dpp(0, v, 0xB1, 0xF, 0xF, false);
    v += __builtin_amdgcn_update_dpp(0, v, 0x4E, 0xF, 0xF, false);
    v += __builtin_amdgcn_update_dpp(0, v, 0x141, 0xF, 0xF, false);
    return v;
}
__device__ __forceinline__ void u_compute(const u32x4 (&w)[16], const PeerVisit& v, int* pd, int lane) {
    const int pg = lane >> 3, sub = lane & 7;
    int d[16];
#pragma unroll
    for (int it = 0; it < 16; ++it) {
        int tl = 0, th = 0;
        tl = __builtin_amdgcn_sdot4((int)(w[it].x & 0x0F0F0F0Fu), (int)v.x.x, tl, false);  th = __builtin_amdgcn_sdot4((int)(w[it].x & 0xF0F0F0F0u), (int)v.x.y, th, false);
        tl = __builtin_amdgcn_sdot4((int)(w[it].y & 0x0F0F0F0Fu), (int)v.x.z, tl, false);  th = __builtin_amdgcn_sdot4((int)(w[it].y & 0xF0F0F0F0u), (int)v.x.w, th, false);
        tl = __builtin_amdgcn_sdot4((int)(w[it].z & 0x0F0F0F0Fu), (int)v.x2.x, tl, false); th = __builtin_amdgcn_sdot4((int)(w[it].z & 0xF0F0F0F0u), (int)v.x2.y, th, false);
        tl = __builtin_amdgcn_sdot4((int)(w[it].w & 0x0F0F0F0Fu), (int)v.x2.z, tl, false); th = __builtin_amdgcn_sdot4((int)(w[it].w & 0xF0F0F0F0u), (int)v.x2.w, th, false);
        const int t = tl * 16 + th;
        d[it] = dpp_add8(t);
    }
    int v0 = d[0], v1 = d[8];
#pragma unroll
    for (int it = 1; it < 8; ++it) { v0 = (sub == it) ? d[it] : v0; v1 = (sub == it) ? d[8 + it] : v1; }
    pd[sub * 8 + pg] = v0; pd[64 + sub * 8 + pg] = v1;
}
typedef int i32x4v __attribute__((ext_vector_type(4)));
__device__ __forceinline__ void v_compute(const u32x4 (&w)[16], const PeerVisit& v, bf16* po, int lane) {
    i32x4v a1[4], a2[4];
#pragma unroll
    for (int q = 0; q < 4; ++q) { a1[q] = (i32x4v){0, 0, 0, 0}; a2[q] = (i32x4v){0, 0, 0, 0}; }
    const unsigned cq[4] = {v.x.x, v.x.y, v.x.z, v.x.w};
    unsigned selq[4];
#pragma unroll
    for (int sI = 0; sI < 4; ++sI) selq[sI] = 0x0C0C0C0Cu ^ ((0x0Cu ^ (unsigned)sI) << (8 * (lane & 3)));
#pragma unroll
    for (int it = 0; it < 16; ++it) {
        const int A = (int)__builtin_amdgcn_perm(0u, cq[it >> 2], selq[it & 3]);
#pragma unroll
        for (int q = 0; q < 4; ++q) {
            a1[q] = __builtin_amdgcn_mfma_i32_4x4x4i8(A, (int)w[it][q], a1[q], 0, 0, 0);
            a2[q] = __builtin_amdgcn_mfma_i32_4x4x4i8(A, (int)(w[it][q] & 0xF0F0F0F0u), a2[q], 0, 0, 0);
        }
    }
    int r1[2][4], r2[2][4];
#pragma unroll
    for (int jj = 0; jj < 2; ++jj)
#pragma unroll
        for (int i = 0; i < 4; ++i) {
            const auto t1 = __builtin_amdgcn_permlane32_swap((unsigned)a1[jj][i], (unsigned)a1[jj + 2][i], false, false); r1[jj][i] = (int)t1[0] + (int)t1[1];
            const auto t2 = __builtin_amdgcn_permlane32_swap((unsigned)a2[jj][i], (unsigned)a2[jj + 2][i], false, false); r2[jj][i] = (int)t2[0] + (int)t2[1];
        }
    int s1[4], s2[4];
#pragma unroll
    for (int i = 0; i < 4; ++i) {
        const auto t1 = __builtin_amdgcn_permlane16_swap((unsigned)r1[0][i], (unsigned)r1[1][i], false, false); s1[i] = (int)t1[0] + (int)t1[1];
        const auto t2 = __builtin_amdgcn_permlane16_swap((unsigned)r2[0][i], (unsigned)r2[1][i], false, false); s2[i] = (int)t2[0] + (int)t2[1];
        s1[i] += __builtin_amdgcn_update_dpp(0, s1[i], 0x128, 0xF, 0xF, false);
        s2[i] += __builtin_amdgcn_update_dpp(0, s2[i], 0x128, 0xF, 0xF, false);
    }
    if (!(lane & 8)) {
        const float csf = (float)v.cs; float lo[4], hi[4];
#pragma unroll
        for (int i = 0; i < 4; ++i) { lo[i] = ((float)(s1[i] - s2[i]) - 7.5f * csf) * v.sc; hi[i] = ((float)s2[i] * 0.0625f + 0.5f * csf) * v.sc; }
        u32x4 o;
        o.x = cvt_pk_bf16(lo[0], lo[1]); o.y = cvt_pk_bf16(lo[2], lo[3]); o.z = cvt_pk_bf16(hi[0], hi[1]); o.w = cvt_pk_bf16(hi[2], hi[3]);
        *(u32x4*)(po + (lane & 7) * 32 + 8 * (((lane >> 4) & 1) + 2 * (lane >> 5))) = o;
    }
}
template <bool VPASS>
__device__ __forceinline__ void peer_pass(Frame& F, int c, int rank, int nblk) {
    const unsigned char* T = F.ws + (VPASS ? WS_PV : WS_PU) + (size_t)c * 16384 * 128; const unsigned char* FQc = F.ws + WS_FQ + c * 256;
    int* PD = (int*)(F.ws + WS_PD) + (size_t)c * NTOK * 128; bf16* PO = (bf16*)(F.ws + WS_PO) + c * 256;
    const int t0 = rank * NWAVES + F.wave, step = nblk * NWAVES;
    if (t0 >= NTOK) return;
    const int nvis = (NTOK - t0 + step - 1) / step;
    int lane = F.lane; asm volatile("" : "+v"(lane));
    PeerVisit va = visit_load<VPASS>(F.ws, FQc, t0, lane), vb = va;
    u32x4 wa[16], wb[16];
    rows16_load(wa, T, va, lane);
    if (nvis > 1) vb = visit_load<VPASS>(F.ws, FQc, t0 + step, lane);
#pragma unroll 1
    for (int v = 0; v < nvis; v += 2) {
        const int tok = t0 + v * step;
        asm volatile("" : "+v"(lane));
        PeerVisit vn = va;
        if (v + 1 < nvis) rows16_load(wb, T, vb, lane);
        if (v + 2 < nvis) vn = visit_load<VPASS>(F.ws, FQc, tok + 2 * step, lane);
        if (VPASS) v_compute(wa, va, PO + (size_t)tok * D, lane); else u_compute(wa, va, PD + (size_t)tok * 128, lane);
        if (v + 1 < nvis) {
            PeerVisit vm = vb;
            if (v + 2 < nvis) rows16_load(wa, T, vn, lane);
            if (v + 3 < nvis) vm = visit_load<VPASS>(F.ws, FQc, tok + 3 * step, lane);
            if (VPASS) v_compute(wb, vb, PO + (size_t)(tok + step) * D, lane); else u_compute(wb, vb, PD + (size_t)(tok + step) * 128, lane);
            vb = vm;
        }
        va = vn;
    }
}
struct CfIn { int d0[8], d1[8]; float fs; int s0, s1; float u0, u1, g0, g1; };
__device__ __forceinline__ void cf_load(CfIn& r, const unsigned char* ws, int tok, int lane) {
#pragma unroll
    for (int c = 0; c < 8; ++c) { const int* pd = (const int*)(ws + WS_PD) + ((size_t)c * NTOK + tok) * 128; r.d0[c] = pd[lane]; r.d1[c] = pd[64 + lane]; }
    r.fs = ((const float*)(ws + WS_FS))[tok]; r.s0 = ((const int*)(ws + WS_FS + (1u << 20)))[2 * tok]; r.s1 = ((const int*)(ws + WS_FS + (1u << 20)))[2 * tok + 1];
    r.u0 = ((const float*)(ws + WS_SELU))[(size_t)tok * 128 + lane]; r.u1 = ((const float*)(ws + WS_SELU))[(size_t)tok * 128 + 64 + lane];
    r.g0 = ((const float*)(ws + WS_SELG))[(size_t)tok * 128 + lane]; r.g1 = ((const float*)(ws + WS_SELG))[(size_t)tok * 128 + 64 + lane];
}
__device__ __forceinline__ void peer_cf(Frame& F) {
    const int lane = F.lane, gw = F.bx * NWAVES + F.wave, NGW = F.G * NWAVES;
    CfIn rn;
    if (gw < NTOK) cf_load(rn, F.ws, gw, lane);
    for (int tok = gw; tok < NTOK; tok += NGW) {
        const CfIn r = rn;
        if (tok + NGW < NTOK) cf_load(rn, F.ws, tok + NGW, lane);
        int d0 = 0, d1 = 0;
#pragma unroll
        for (int c = 0; c < 8; ++c) { d0 += r.d0[c]; d1 += r.d1[c]; }
        const float foff = 7.5f * (float)r.s0 - 0.5f * (float)r.s1;
        const float c0 = r.g0 * gelu_f(((float)d0 * 0.0625f - foff) * (r.u0 * r.fs)), c1 = r.g1 * gelu_f(((float)d1 * 0.0625f - foff) * (r.u1 * r.fs));
        float am = fmaxf(fabsf(c0), fabsf(c1));
#pragma unroll
        for (int o = 1; o < 64; o <<= 1) am = fmaxf(am, shx(am, o, lane));
        const float inv = am > 0.f ? 127.f / am : 0.f;
        const int q0 = (int)rintf(c0 * inv), q1 = (int)rintf(c1 * inv);
        unsigned char* cq = F.ws + WS_CFQ + (size_t)tok * 128;
        cq[(lane & 7) * 16 + (lane >> 3)] = (unsigned char)(q0 & 255); cq[(lane & 7) * 16 + 8 + (lane >> 3)] = (unsigned char)(q1 & 255);
        int qs = q0 + q1;
#pragma unroll
        for (int o = 1; o < 64; o <<= 1) qs += shx(qs, o, lane);
        if (lane == 0) { ((float*)(F.ws + WS_CS))[2 * tok] = am * (1.f / 127.f); ((int*)(F.ws + WS_CS))[2 * tok + 1] = qs; }
    }
}
struct FinalRow { u32x2 m[8], q[8]; };
__device__ __forceinline__ void final_row_load(FinalRow& r, const Params& p, const unsigned char* ws, int tok, int lane) {
    const bf16* mrow = (const bf16*)(ws + WS_MIX) + (size_t)tok * D; const bf16* prow = (const bf16*)(ws + WS_PO) + (size_t)tok * D;
#pragma unroll
    for (int j = 0; j < 8; ++j) { const int el = 4 * lane + 256 * j; r.m[j] = *(const u32x2*)(mrow + el); r.q[j] = *(const u32x2*)(prow + el); }
}
__device__ __forceinline__ void peer_final(Frame& F, const Params& p) {
    const float* modf = (const float*)(F.ws + WS_MODF);
    const int lane = F.lane, gw = F.bx * NWAVES + F.wave, NGW = F.G * NWAVES;
    FinalRow rn;
    if (gw < NTOK) final_row_load(rn, p, F.ws, gw, lane);
    for (int tok = gw; tok < NTOK; tok += NGW) {
        FinalRow r = rn;
        if (tok + NGW < NTOK) final_row_load(rn, p, F.ws, tok + NGW, lane);
        float* hrow = p.out + (size_t)tok * D;
        const float* m5 = modf + (size_t)(tok >> 14) * 12288 + 5 * D; float ss = 0.f;
        f32x4 v[8];
#pragma unroll
        for (int j = 0; j < 8; ++j) {
            const int el = 4 * lane + 256 * j; const f32x4 g4 = *(const f32x4*)(m5 + el);
            const float mf[4] = {bf_lo(r.m[j].x), bf_hi(r.m[j].x), bf_lo(r.m[j].y), bf_hi(r.m[j].y)}, pf[4] = {bf_lo(r.q[j].x), bf_hi(r.q[j].x), bf_lo(r.q[j].y), bf_hi(r.q[j].y)};
#pragma unroll
            for (int i = 0; i < 4; ++i) { const float t = mf[i] + g4[i] * pf[i]; v[j][i] = t; ss += t * t; }
        }
        const float rstd = rsqrtf(wave_sum(ss, lane) * (1.f / D) + 1e-6f);
#pragma unroll
        for (int j = 0; j < 8; ++j) {
            const int el = 4 * lane + 256 * j; const f32x4 gf = *(const f32x4*)(p.in[32] + el);
            *(f32x4*)(hrow + el) = (f32x4){v[j][0] * rstd * gf[0], v[j][1] * rstd * gf[1], v[j][2] * rstd * gf[2], v[j][3] * rstd * gf[3]};
        }
    }
}

#ifndef DUPMASK
#define DUPMASK 0
#endif
#define REFRESH() do { F.lane = lane_id(); F.tid = F.wave * 64 + F.lane; } while (0)
#define RUNPH(n, ...) do { REFRESH(); { __VA_ARGS__ } if ((DUPMASK >> (n)) & 1) { grid.sync(); REFRESH(); { __VA_ARGS__ } } } while (0)
__global__ void __launch_bounds__(NTHREADS, 2) fwd_megakernel(Params p) {
    extern __shared__ __attribute__((aligned(16))) unsigned char lds_raw[];
    cg::grid_group grid = cg::this_grid();
    Frame F; F.lds = (LAS unsigned char*)lds_raw; F.tid = threadIdx.x; F.lane = F.tid & 63; F.wave = __builtin_amdgcn_readfirstlane(F.tid >> 6); F.G = gridDim.x; F.bx = blockIdx.x; F.ws = p.ws;
    volatile LAS unsigned* bst = (volatile LAS unsigned*)(F.lds + LDS_BYTES - 16);
    if (F.tid < 4) bst[F.tid] = 0u;
    __syncthreads();
    const XcdBarrier xbar = xcd_barrier_post((unsigned*)(p.ws), bst, F.tid == 0);
    if (F.tid == 0) { bst[2] = xb_add((unsigned*)p.ws + CW_RANK + 64 * xbar.x, 1u); bst[3] = xb_add((unsigned*)p.ws + CW_TICKET, 1u); }
#define GSYNC() xcd_barrier(xbar, (F.wave == 0) && (lane_id() == 0))

    RUNPH(0, phase0a(F, p););
    if (DUPMASK & 0x700000) { grid.sync(); REFRESH(); phase0a(F, p, (DUPMASK >> 20) & 7); }
    if (p.out == nullptr) grid.sync();
    GSYNC();
    RUNPH(1, phase_norm(F, p, 0););
    GSYNC();
    RUNPH(2, ctx_in_gemm(F); big_gemm(F, p, pg8::EM_IN, F.ws + WS_NBUF, D, F.ws + WS_WIN, D, NTOK, 3072, D);
        REFRESH();
        pg8::Sched S; S.A = (const char*)(F.ws + WS_NBUF8); S.B = (const char*)(F.ws + WS_WIN8); S.gA = 0; S.gB = 0; S.lda = D; S.ldb = D; S.nM = NTOK / 256; S.nN = 4096 / 256; S.nG = 1; S.G = F.G; S.c = F.bx;
        S.A2 = S.A; S.B2 = S.B; S.pair = 0; S.esz = 1;
        pg8::Epi E; E.mode = pg8::EM_ING; E.ws = F.ws; E.x = p.in[0]; E.out = p.out; E.modf = (const float*)(F.ws + WS_MODF);
        pg8::gemm_phase<true>(F.lds, D, S, E, F.wave););
    if (DUPMASK & 0x8000) { GSYNC(); REFRESH(); big_gemm(F, p, pg8::EM_PROBE, F.ws + WS_NBUF, D, F.ws + WS_WIN, D, NTOK, D, D); }
    GSYNC();
    RUNPH(3,
        pg8::Sched S; S.A = (const char*)(F.ws + WS_X); S.B = (const char*)(F.ws + WS_MS); S.gA = (size_t)NCHUNK * XK * 2; S.gB = (size_t)256 * 512 * 2; S.lda = XK; S.ldb = 512; S.nM = 4; S.nN = 1; S.nG = 64; S.G = F.G; S.c = F.bx; S.A2 = S.A; S.B2 = S.B; S.pair = 0; S.esz = 2;
        pg8::Epi E; E.mode = pg8::EM_S5S; E.ws = F.ws; E.x = p.in[0]; E.out = p.out; E.modf = (const float*)(F.ws + WS_MODF);
        pg8::gemm_phase(F.lds, 512, S, E, F.wave);
        REFRESH(); ctx_s5_states(F);
        lru_phase<1>(F, p); if (DUPMASK & 0x1000) { GSYNC(); REFRESH(); lru_phase<1>(F, p); });
    GSYNC();
    RUNPH(4, phase_carry(F, p););
    GSYNC();
    RUNPH(5,
        pg8::Sched S; S.A = (const char*)(F.ws + WS_X); S.B = (const char*)(F.ws + WS_MFULL); S.gA = (size_t)NCHUNK * XK * 2; S.gB = (size_t)512 * XK * 2; S.lda = XK; S.ldb = XK; S.nM = 4; S.nN = 2; S.nG = 64; S.G = F.G; S.c = F.bx; S.A2 = S.A; S.B2 = S.B; S.pair = 0; S.esz = 2;
        pg8::Epi E; E.mode = pg8::EM_S5Y; E.ws = F.ws; E.x = p.in[0]; E.out = p.out; E.modf = (const float*)(F.ws + WS_MODF);
        pg8::gemm_phase(F.lds, XK, S, E, F.wave);
        REFRESH(); lru_phase<2>(F, p); if (DUPMASK & 0x2000) { GSYNC(); REFRESH(); lru_phase<2>(F, p); });
    GSYNC();
    RUNPH(6, big_gemm(F, p, pg8::EM_GLU, F.ws + WS_ZA, S5W, F.ws + WS_WGLU, S5W, NTOK, S5W, S5W););
    GSYNC();
    RUNPH(7,
        pg8::Sched S; S.A = (const char*)(F.ws + WS_YA); S.B = (const char*)(F.ws + WS_WPA); S.A2 = (const char*)(F.ws + WS_YB); S.B2 = (const char*)(F.ws + WS_WPB); S.pair = 1; S.esz = 2;
        S.gA = 0; S.gB = 0; S.lda = S5W; S.ldb = S5W; S.nM = NTOK / 256; S.nN = D / 256; S.nG = 1; S.G = F.G; S.c = F.bx;
        pg8::Epi E; E.mode = pg8::EM_PAB; E.ws = F.ws; E.x = p.in[0]; E.out = p.out; E.modf = (const float*)(F.ws + WS_MODF);
        pg8::gemm_phase(F.lds, S5W, S, E, F.wave););
    GSYNC();
    RUNPH(8, big_gemm(F, p, pg8::EM_OUT, F.ws + WS_NBUF, D, F.ws + WS_WOUT, D, NTOK, D, D););
    GSYNC();
    RUNPH(9, phase_norm(F, p, 1););
    GSYNC();
    RUNPH(10, big_gemm(F, p, pg8::EM_Q, F.ws + WS_NBUF, D, F.ws + WS_WQ, D, NTOK, D, D););
    GSYNC();
    if (DUPMASK & 0x4000) { for (int i = 0; i < 10; ++i) GSYNC(); }
    REFRESH(); peer_phase(F, p);
    if (DUPMASK & 0x8000) { GSYNC(); REFRESH(); peer_phase(F, p, (DUPMASK >> 24) & 7); }
    GSYNC();
    {
        int sp, rank, nblk;
        {
            unsigned* bar = (unsigned*)p.ws; bool ok = true; unsigned mine = 0;
            for (unsigned j = 0; j < 16; ++j) { const unsigned cnt = xb_ld(&bar[XB_XCNT(j)]); if ((j < 8) != (cnt > 0u)) ok = false; if (j == xbar.x) mine = cnt; }
            const unsigned tk = bst[3];
            if (ok) { sp = (int)xbar.x; rank = (int)bst[2]; nblk = (int)mine; }
            else { sp = (int)(tk & 7u); rank = (int)(tk >> 3); nblk = (int)((F.G + 7 - (tk & 7u)) / 8); }
            sp = __builtin_amdgcn_readfirstlane(sp); rank = __builtin_amdgcn_readfirstlane(rank); nblk = __builtin_amdgcn_readfirstlane(nblk);
        }
        REFRESH(); peer_pass<false>(F, sp, rank, nblk);
        if (DUPMASK & 0x10000) { GSYNC(); REFRESH(); peer_pass<false>(F, sp, rank, nblk); }
        GSYNC();
        REFRESH(); peer_cf(F);
        if (DUPMASK & 0x20000) { GSYNC(); REFRESH(); peer_cf(F); }
        GSYNC();
        REFRESH(); peer_pass<true>(F, sp, rank, nblk);
        if (DUPMASK & 0x40000) { GSYNC(); REFRESH(); peer_pass<true>(F, sp, rank, nblk); }
        GSYNC();
        REFRESH(); peer_final(F, p);
        if (DUPMASK & 0x80000) { GSYNC(); REFRESH(); peer_final(F, p); }
    }
}

extern "C" void kernel_launch(void* const* d_in, const int* in_sizes, int n_in, void* d_out, int out_size, void* d_ws, size_t ws_size, hipStream_t stream) {
    static int grid_blocks = 0;
    if (!grid_blocks) {
        int dev = 0, cus = 0, per_cu = 0;
        (void)hipGetDevice(&dev);
        (void)hipDeviceGetAttribute(&cus, hipDeviceAttributeMultiprocessorCount, dev);
        (void)hipFuncSetAttribute((const void*)fwd_megakernel, hipFuncAttributeMaxDynamicSharedMemorySize, LDS_BYTES);
        (void)hipOccupancyMaxActiveBlocksPerMultiprocessor(&per_cu, (const void*)fwd_megakernel, NTHREADS, LDS_BYTES);
        if (per_cu < 1) per_cu = 1;
        grid_blocks = cus;
        if (ws_size < WS_END) { fprintf(stderr, "kernel_launch: workspace too small (%zu < %zu)\n", ws_size, (size_t)WS_END); grid_blocks = -1; }
    }
    if (grid_blocks < 0) return;
    (void)hipMemsetAsync(d_ws, 0, 65536, stream);
    Params p{};
    for (int i = 0; i < 33; ++i) p.in[i] = (const float*)d_in[i];
    p.out = (float*)d_out; p.ws = (unsigned char*)d_ws;
    void* args[] = {&p};
    hipError_t e = hipLaunchCooperativeKernel((const void*)fwd_megakernel, dim3(grid_blocks), dim3(NTHREADS), args, LDS_BYTES, stream);
    if (e != hipSuccess) fprintf(stderr, "cooperative launch failed: %s (grid %d)\n", hipGetErrorString(e), grid_blocks);
}
```

```cpp
#include <hip/hip_runtime.h>
#include <hip/hip_cooperative_groups.h>
#include <cstdio>
#include <cstdint>
namespace cg = cooperative_groups;

#define LAS __attribute__((address_space(3)))
typedef unsigned short bf16;
typedef short bf16x8 __attribute__((ext_vector_type(8)));
typedef float f32x4 __attribute__((ext_vector_type(4)));
typedef float f32x16 __attribute__((ext_vector_type(16)));
typedef unsigned u32x4 __attribute__((ext_vector_type(4)));
typedef unsigned u32x2 __attribute__((ext_vector_type(2)));

constexpr int D = 2048, NB = 2, SEQ = 16384, NTOK = NB * SEQ, CTXL = 256, NCTXT = NB * CTXL;
constexpr int S5W = 1024, LRUW = 1024, INW = 7168;
constexpr int NTHREADS = 512, NWAVES = 8;
constexpr int LDS_BYTES = 147456;
constexpr int TCH = 32;
constexpr int NCHUNK = NTOK / TCH;
constexpr int XK = 768;
constexpr int NQ = 520;
constexpr int KSL = 16;

constexpr size_t MiB = 1ull << 20;
constexpr size_t WS_MODP = 1 * MiB;
constexpr size_t WS_MODF = 6 * MiB;
constexpr size_t WS_WIN = 8 * MiB;
constexpr size_t WS_CMAX = 65536;
constexpr size_t WS_RS = 131072;
constexpr size_t WS_NBUF8 = 864 * MiB;
constexpr size_t WS_WINI8 = 256 * MiB;
constexpr size_t WS_WGLU = 36 * MiB;
constexpr size_t WS_WPA = 38 * MiB;
constexpr size_t WS_WPB = 42 * MiB;
constexpr size_t WS_WOUT = 46 * MiB;
constexpr size_t WS_WQ = 54 * MiB;
constexpr size_t WS_SKB = 62 * MiB;
constexpr size_t WS_LW = 63 * MiB;
constexpr size_t WS_MFULL = 64 * MiB;
constexpr size_t WS_MS = 112 * MiB;
constexpr size_t WS_PU = 128 * MiB;
constexpr size_t WS_PV = 160 * MiB;
constexpr size_t WS_SU = 192 * MiB;
constexpr size_t WS_SV = 192 * MiB + 65536;
constexpr size_t WS_NBUF = 256 * MiB;
constexpr size_t WS_SBUF = 256 * MiB;
constexpr size_t WS_PL = 320 * MiB;
constexpr size_t WS_LC = 338 * MiB;
constexpr size_t WS_X = 384 * MiB;
constexpr size_t WS_YA = 384 * MiB;
constexpr size_t WS_V = 480 * MiB;
constexpr size_t WS_GG = 544 * MiB;
constexpr size_t WS_SA = 608 * MiB;
constexpr size_t WS_Q = 608 * MiB;
constexpr size_t WS_SB = 736 * MiB;
constexpr size_t WS_MIX = 736 * MiB;
constexpr size_t WS_ZA = 864 * MiB;
constexpr size_t WS_YB = 928 * MiB;
constexpr size_t WS_NCTX = 992 * MiB;
constexpr size_t WS_XC = 994 * MiB;
constexpr size_t WS_VC = 995 * MiB;
constexpr size_t WS_SC = 996 * MiB;
constexpr size_t WS_SELE = 194 * MiB;
constexpr size_t WS_SELG = 210 * MiB;
constexpr size_t WS_SELU = 226 * MiB;
constexpr size_t WS_FQ = 384 * MiB;
constexpr size_t WS_FS = 448 * MiB;
constexpr size_t WS_PD = 480 * MiB;
constexpr size_t WS_CFQ = 864 * MiB;
constexpr size_t WS_CS = 880 * MiB;
constexpr size_t WS_PO = 256 * MiB;
constexpr size_t WS_END = 1024 * MiB;
constexpr int CW_RANK = 4096;
constexpr int CW_TICKET = 8192;

struct Params {
    const float* in[33];
    float* out;
    unsigned char* ws;
};

__device__ __forceinline__ unsigned f2bf(float f) { unsigned u = __float_as_uint(f); return (u + 0x7fffu + ((u >> 16) & 1u)) >> 16; }
__device__ __forceinline__ unsigned pk2(float lo, float hi) { return f2bf(lo) | (f2bf(hi) << 16); }
__device__ __forceinline__ unsigned cvt_pk_bf16(float lo, float hi) { unsigned r; asm volatile("v_cvt_pk_bf16_f32 %0, %1, %2" : "=v"(r) : "v"(lo), "v"(hi)); return r; }
__device__ __forceinline__ float bf_lo(unsigned w) { return __uint_as_float(w << 16); }
__device__ __forceinline__ float bf_hi(unsigned w) { return __uint_as_float(w & 0xffff0000u); }
__device__ __forceinline__ float sigmoid_f(float x) { return __builtin_amdgcn_rcpf(1.f + __expf(-x)); }
__device__ __forceinline__ float gelu_f(float x) { const float u = 1.5957691216057308f * (x + 0.044715f * x * x * x); return x * __builtin_amdgcn_rcpf(1.f + __expf(-u)); }
__device__ __forceinline__ float shx(float v, int o, int lane) { return __int_as_float(__builtin_amdgcn_ds_bpermute((lane ^ o) << 2, __float_as_int(v))); }
__device__ __forceinline__ int shx(int v, int o, int lane) { return __builtin_amdgcn_ds_bpermute((lane ^ o) << 2, v); }
__device__ __forceinline__ float wave_sum(float v, int lane) {
#pragma unroll
    for (int o = 1; o < 64; o <<= 1) v += shx(v, o, lane);
    return v;
}
#define LDS_WAIT() asm volatile("s_waitcnt lgkmcnt(0)" ::: "memory")
__device__ __forceinline__ int lane_id() { int l; asm volatile("v_mbcnt_lo_u32_b32 %0, -1, 0\n\tv_mbcnt_hi_u32_b32 %0, -1, %0" : "=v"(l)); return l; }
__device__ __forceinline__ int opaque_tid(int wave_s) { return wave_s * 64 + lane_id(); }

namespace pg8 {
constexpr int BM = 256, BK = 64, HALF = 128, HTB = HALF * BK * 2, STAGE_BYTES = 8 * HTB, NXCD = 8, WGM = 8;
__device__ __forceinline__ int lds_byte(int r, int c) { const int st = (r >> 4) * 2 + (c >> 5), rr = r & 15, cc = c & 31, ob = rr * 64 + cc * 2; return st * 1024 + (ob ^ (((ob >> 9) & 1) << 5)); }
__device__ __forceinline__ void stage_rc(int b, int& R, int& C) { const int st = b / 1024, sb = b % 1024, swz = sb ^ (((sb >> 9) & 1) << 5); R = (st >> 1) * 16 + swz / 64; C = (st & 1) * 32 + (swz % 64) / 2; }
__device__ __forceinline__ int perm32(int rho) { const int n = rho >> 4, i = rho & 15; return 8 * (i >> 2) + 4 * n + (i & 3); }

struct Unit { const char* A; const char* B; int g, pm, pn, ph; };

struct Sched {
    const char* A; const char* B; size_t gA, gB; int lda, ldb, nM, nN, nG, G, c;
    const char* A2; const char* B2; int pair; int esz;
    __device__ __forceinline__ bool next(int i0, Unit& u) const {
        const int i = pair ? (i0 >> 1) : i0; u.ph = pair ? (i0 & 1) : 0;
        const long L = (long)i * G + c; const int per = nM * nN; if (L >= (long)per * nG) return false;
        const int g = (int)(L / per); int wgid = (int)(L % per); int pm, pn;
        if (nG == 1) {
            const int nwg = per; { const int q = nwg / NXCD, r = nwg % NXCD, xcd = wgid % NXCD, off = wgid / NXCD; wgid = (xcd < r ? xcd * (q + 1) : r * (q + 1) + (xcd - r) * q) + off; }
            const int nig = WGM * nN, gid = wgid / nig, fm = gid * WGM, gsz = (nM - fm) < WGM ? (nM - fm) : WGM;
            pm = fm + ((wgid % nig) % gsz); pn = (wgid % nig) / gsz;
        } else { pm = wgid % nM; pn = wgid / nM; }
        u.g = g; u.pm = pm; u.pn = pn;
        u.A = (u.ph ? A2 : A) + (size_t)g * gA + (size_t)pm * BM * lda * esz; u.B = (u.ph ? B2 : B) + (size_t)g * gB + (size_t)pn * BM * ldb * esz;
        return true;
    }
};

enum EpiMode { EM_IN = 0, EM_ING, EM_S5S, EM_S5Y, EM_GLU, EM_PAB, EM_OUT, EM_Q, EM_PROBE };
struct Epi {
    int mode;
    unsigned char* ws; const float* x; float* out; const float* modf;
    __device__ __forceinline__ void store8(bf16* p, const float (&v)[8]) const {
        u32x4 w; w.x = cvt_pk_bf16(v[0], v[1]); w.y = cvt_pk_bf16(v[2], v[3]); w.z = cvt_pk_bf16(v[4], v[5]); w.w = cvt_pk_bf16(v[6], v[7]);
        *(u32x4*)p = w;
    }
    __device__ __forceinline__ void in8(f32x4 (&acc)[2][2][4][2], const Unit& u, int wr, int wc, int fr, int fq) const {
        const float* cmax = (const float*)(ws + WS_CMAX); const float* rsv = (const float*)(ws + WS_RS);
        float csc[2][8];
#pragma unroll
        for (int bj = 0; bj < 2; ++bj) {
            const int col = u.pn * BM + bj * HALF + wc * 32 + 8 * fq; const f32x4 c0 = *(const f32x4*)(cmax + col), c1 = *(const f32x4*)(cmax + col + 4);
#pragma unroll
            for (int j = 0; j < 4; ++j) { csc[bj][j] = c0[j] * (1.f / 127.f); csc[bj][4 + j] = c1[j] * (1.f / 127.f); }
        }
#pragma unroll
        for (int ai = 0; ai < 2; ++ai)
#pragma unroll
            for (int m = 0; m < 4; ++m) {
                const int row = u.pm * BM + ai * HALF + wr * 64 + m * 16 + fr; const float rsc = rsv[row];
                float z[2][8];
#pragma unroll
                for (int bj = 0; bj < 2; ++bj)
#pragma unroll
                    for (int j = 0; j < 8; ++j) { const float af = acc[ai][bj][m][j >> 2][j & 3]; z[bj][j] = (float)__float_as_int(af) * (rsc * csc[bj][j]); }
                if (u.pn >= 12) {
                    const int dcol = (u.pn - 12) * HALF + wc * 32 + 8 * fq;
                    float ra[8], sb[8];
#pragma unroll
                    for (int j = 0; j < 8; ++j) {
                        const float ea = __expf(-z[0][j]), eb = __expf(-fmaxf(z[1][j], -30.f));
                        sb[j] = __builtin_amdgcn_rcpf(1.f + eb);
                        ra[j] = (1.f + eb) * __builtin_amdgcn_rcpf(1.f + ea);
                    }
                    store8((bf16*)(ws + WS_SA) + (size_t)row * D + dcol, ra);
                    store8((bf16*)(ws + WS_SB) + (size_t)row * D + dcol, sb);
                } else {
#pragma unroll
                    for (int bj = 0; bj < 2; ++bj) {
                        const int col = u.pn * BM + bj * HALF + wc * 32 + 8 * fq;
                        if (u.pn < 4) {
                            const int g = col >> 4, h0 = col & 15;
                            store8((bf16*)(ws + WS_X) + ((size_t)(g * NCHUNK + (row >> 5)) * XK + (row & 31) * 16 + h0), z[bj]);
                        } else if (u.pn < 8) {
                            store8((bf16*)(ws + WS_V) + (size_t)row * LRUW + (col - 1024), z[bj]);
                        } else {
                            float gv[8];
#pragma unroll
                            for (int j = 0; j < 8; ++j) gv[j] = gelu_f(z[bj][j]);
                            store8((bf16*)(ws + WS_GG) + (size_t)row * LRUW + (col - 2048), gv);
                        }
                    }
                }
            }
    }
    __device__ __forceinline__ void operator()(f32x4 (&acc)[2][2][4][2], const Unit& u, int wr, int wc, int fr, int fq) const {
        if (mode == EM_GLU || mode == EM_PAB) {
            const int ld = (mode == EM_GLU) ? S5W : D;
            const bf16* g0 = (const bf16*)(ws + (mode == EM_GLU ? WS_ZA : (u.ph == 0 ? WS_SA : WS_SB)));
            u32x4 zq[2][4][2];
#pragma unroll
            for (int ai = 0; ai < 2; ++ai)
#pragma unroll
                for (int m = 0; m < 4; ++m)
#pragma unroll
                    for (int bj = 0; bj < 2; ++bj) {
                        const int row = u.pm * BM + ai * HALF + wr * 64 + m * 16 + fr, col = u.pn * BM + bj * HALF + wc * 32 + 8 * fq;
                        zq[ai][m][bj] = *(const u32x4*)(g0 + (size_t)row * ld + col);
                    }
#pragma unroll
            for (int ai = 0; ai < 2; ++ai) {
#pragma unroll
                for (int m = 0; m < 4; ++m)
#pragma unroll
                    for (int bj = 0; bj < 2; ++bj) {
                        const int row = u.pm * BM + ai * HALF + wr * 64 + m * 16 + fr, col = u.pn * BM + bj * HALF + wc * 32 + 8 * fq;
                        const u32x4 z = zq[ai][m][bj];
                        const float zf[8] = {bf_lo(z.x), bf_hi(z.x), bf_lo(z.y), bf_hi(z.y), bf_lo(z.z), bf_hi(z.z), bf_lo(z.w), bf_hi(z.w)};
                        if (mode == EM_PAB && u.ph == 0) {
#pragma unroll
                            for (int j = 0; j < 4; ++j) { acc[ai][bj][m][0][j] *= zf[j]; acc[ai][bj][m][1][j] *= zf[4 + j]; }
                        } else {
                            float v[8];
#pragma unroll
                            for (int j = 0; j < 4; ++j) { v[j] = acc[ai][bj][m][0][j]; v[4 + j] = acc[ai][bj][m][1][j]; }
                            if (mode == EM_GLU) {
#pragma unroll
                                for (int j = 0; j < 8; ++j) v[j] = zf[j] * sigmoid_f(v[j]);
                                store8((bf16*)(ws + WS_YA) + (size_t)row * S5W + col, v);
                            } else {
#pragma unroll
                                for (int j = 0; j < 8; ++j) v[j] *= zf[j];
                                store8((bf16*)(ws + WS_NBUF) + (size_t)row * D + col, v);
                            }
                        }
                    }
            }
            return;
        }
        if (mode == EM_OUT) {
            const float* m2 = modf + (size_t)((u.pm * BM) >> 14) * 12288 + 2 * D;
            f32x4 gq[2][2];
#pragma unroll
            for (int bj = 0; bj < 2; ++bj) { const int col = u.pn * BM + bj * HALF + wc * 32 + 8 * fq; gq[bj][0] = *(const f32x4*)(m2 + col); gq[bj][1] = *(const f32x4*)(m2 + col + 4); }
#pragma unroll
            for (int ai = 0; ai < 2; ++ai) {
                f32x4 xq[4][2][2];
#pragma unroll
                for (int m = 0; m < 4; ++m)
#pragma unroll
                    for (int bj = 0; bj < 2; ++bj) {
                        const int row = u.pm * BM + ai * HALF + wr * 64 + m * 16 + fr, col = u.pn * BM + bj * HALF + wc * 32 + 8 * fq;
                        xq[m][bj][0] = *(const f32x4*)(x + (size_t)row * D + col); xq[m][bj][1] = *(const f32x4*)(x + (size_t)row * D + col + 4);
                    }
#pragma unroll
                for (int m = 0; m < 4; ++m)
#pragma unroll
                    for (int bj = 0; bj < 2; ++bj) {
                        const int row = u.pm * BM + ai * HALF + wr * 64 + m * 16 + fr, col = u.pn * BM + bj * HALF + wc * 32 + 8 * fq;
                        float v[8];
#pragma unroll
                        for (int j = 0; j < 4; ++j) { v[j] = xq[m][bj][0][j] + gq[bj][0][j] * acc[ai][bj][m][0][j]; v[4 + j] = xq[m][bj][1][j] + gq[bj][1][j] * acc[ai][bj][m][1][j]; }
                        store8((bf16*)(ws + WS_MIX) + (size_t)row * D + col, v);
                    }
            }
            return;
        }
#pragma unroll
        for (int ai = 0; ai < 2; ++ai)
#pragma unroll
            for (int m = 0; m < 4; ++m) {
                const int row = u.pm * BM + ai * HALF + wr * 64 + m * 16 + fr;
#pragma unroll
                for (int bj = 0; bj < 2; ++bj) {
                    const int col = u.pn * BM + bj * HALF + wc * 32 + 8 * fq;
                    float v[8];
#pragma unroll
                    for (int j = 0; j < 4; ++j) { v[j] = acc[ai][bj][m][0][j]; v[4 + j] = acc[ai][bj][m][1][j]; }
                    if (mode == EM_IN) {
                    } else if (mode == EM_S5S) {
                        float* p = (float*)(ws + WS_SBUF) + ((size_t)(u.g * NCHUNK + row) * 256 + col);
                        *(f32x4*)p = (f32x4){v[0], v[1], v[2], v[3]}; *(f32x4*)(p + 4) = (f32x4){v[4], v[5], v[6], v[7]};
                    } else if (mode == EM_S5Y) {
                        const int tok = row * TCH + (col >> 4), ch = u.g * 16 + (col & 15);
#pragma unroll
                        for (int j = 0; j < 8; ++j) v[j] = gelu_f(v[j]);
                        store8((bf16*)(ws + WS_ZA) + (size_t)tok * S5W + ch, v);
                    } else if (mode == EM_PROBE) {
                        asm volatile("" :: "v"(v[0]), "v"(v[1]), "v"(v[2]), "v"(v[3]), "v"(v[4]), "v"(v[5]), "v"(v[6]), "v"(v[7]));
                    } else {
                        store8((bf16*)(ws + WS_Q) + (size_t)row * D + col, v);
                    }
                }
            }
    }
};

typedef int i32x4g __attribute__((ext_vector_type(4)));
typedef int i32x8g __attribute__((ext_vector_type(8)));
typedef long i64x2g __attribute__((ext_vector_type(2)));
__device__ __forceinline__ i32x8g cat8(const bf16x8& lo, const bf16x8& hi) { return __builtin_shufflevector(__builtin_bit_cast(i32x4g, lo), __builtin_bit_cast(i32x4g, hi), 0, 1, 2, 3, 4, 5, 6, 7); }
template <bool F8 = false>
__device__ __forceinline__ void gemm_phase(LAS unsigned char* lds, const int K, const Sched& S, const Epi& E, const int wave_s) {
    const int tid = opaque_tid(wave_s), wid = wave_s, lane = tid & 63, wr = wid >> 2, wc = wid & 3, fr = lane & 15, fq = lane >> 4;
    const int nt = F8 ? K / (2 * BK) : K / BK, lda = F8 ? S.lda / 2 : S.lda, ldb = F8 ? S.ldb / 2 : S.ldb;
    const bool align = true;
    unsigned voffA[2], voffB[2];
#pragma unroll
    for (int i = 0; i < 2; ++i) { int R, C; stage_rc(tid * 16 + i * 8192, R, C); const int Rb = (R & ~31) + perm32(R & 31);
        voffA[i] = (unsigned)(R * lda + C) * 2u; voffB[i] = (unsigned)(Rb * ldb + C) * 2u;
        if (E.mode == EM_PROBE) { voffA[i] = voffB[i] = (unsigned)(tid * 16 + i * 8192); } }
    const size_t kstep = (E.mode == EM_PROBE) ? (size_t)32768 : (size_t)(BK * 2);
    const size_t hstepA = (E.mode == EM_PROBE) ? (size_t)16384 : (size_t)HALF * lda * 2, hstepB = (E.mode == EM_PROBE) ? (size_t)16384 : (size_t)HALF * ldb * 2;
    const unsigned ldsw = (unsigned)wid * 1024u;
    const int aoff = lds_byte(wr * 64 + fr, fq * 8), boff = lds_byte(wc * 32 + fr, fq * 8);
#define PG8_SA(b, h) (((b) * 2 + (h)) * HTB)
#define PG8_SB(b, h) ((4 + (b) * 2 + (h)) * HTB)
#define PG8_STAGE(bufoff, gbase, voff) do { _Pragma("unroll") for (int _i = 0; _i < 2; ++_i) { unsigned _vo = (voff)[_i]; asm volatile("" : "+v"(_vo));   \
        __builtin_amdgcn_global_load_lds((const unsigned*)((const char*)(gbase) + _vo), (LAS unsigned*)(lds + (bufoff) + ldsw + _i * 8192), 16, 0, 0); } } while (0)
#define PG8_LDA(dst, b, h) do { _Pragma("unroll") for (int m = 0; m < 4; ++m) _Pragma("unroll") for (int k = 0; k < 2; ++k) dst[m][k] = *(const LAS bf16x8*)(lds + PG8_SA(b, h) + aoff + m * 2048 + k * 1024); } while (0)
#define PG8_LDB(dst, b, h) do { _Pragma("unroll") for (int n = 0; n < 2; ++n) _Pragma("unroll") for (int k = 0; k < 2; ++k) dst[n][k] = *(const LAS bf16x8*)(lds + PG8_SB(b, h) + boff + n * 2048 + k * 1024); } while (0)
#define PG8_MMA(ai, bj, At, Bt) do { __builtin_amdgcn_s_setprio(1); \
        if (F8) { _Pragma("unroll") for (int m = 0; m < 4; ++m) _Pragma("unroll") for (int n = 0; n < 2; ++n) _Pragma("unroll") for (int k = 0; k < 2; ++k) \
            acc[ai][bj][m][n] = __builtin_bit_cast(f32x4, __builtin_amdgcn_mfma_i32_16x16x64_i8(__builtin_bit_cast(i32x4g, Bt[n][k]), __builtin_bit_cast(i32x4g, At[m][k]), __builtin_bit_cast(i32x4g, acc[ai][bj][m][n]), 0, 0, 0)); } \
        else { _Pragma("unroll") for (int m = 0; m < 4; ++m) _Pragma("unroll") for (int n = 0; n < 2; ++n) _Pragma("unroll") for (int k = 0; k < 2; ++k) \
            acc[ai][bj][m][n] = __builtin_amdgcn_mfma_f32_16x16x32_bf16(Bt[n][k], At[m][k], acc[ai][bj][m][n], 0, 0, 0); } \
        __builtin_amdgcn_s_setprio(0); } while (0)
#define PG8_WAIT_V(n) asm volatile("s_waitcnt vmcnt(" #n ")" ::: "memory")
#define PG8_WAIT_L(n) asm volatile("s_waitcnt lgkmcnt(" #n ")" ::: "memory")
#define PG8_BAR __builtin_amdgcn_s_barrier()
#define PG8_SCHED __builtin_amdgcn_sched_barrier(0)
    Unit cur, nxt; int ui = 0;
    if (!S.next(0, cur)) return;
    f32x4 acc[2][2][4][2];
#pragma unroll
    for (int a = 0; a < 2; ++a)
#pragma unroll
        for (int b = 0; b < 2; ++b)
#pragma unroll
            for (int m = 0; m < 4; ++m)
#pragma unroll
                for (int n = 0; n < 2; ++n) acc[a][b][m][n] = (f32x4){0.f, 0.f, 0.f, 0.f};
    bf16x8 At[4][2], B0[2][2], B1[2][2];
    const char* cA = cur.A; const char* cB = cur.B;
    PG8_STAGE(PG8_SB(0, 0), cB, voffB); PG8_STAGE(PG8_SB(0, 1), cB + hstepB, voffB); PG8_STAGE(PG8_SA(0, 0), cA, voffA); PG8_STAGE(PG8_SA(0, 1), cA + hstepA, voffA);
    if (wr == 1) PG8_BAR;
    PG8_WAIT_V(2); PG8_BAR;
    PG8_STAGE(PG8_SB(1, 0), cB + kstep, voffB); PG8_STAGE(PG8_SA(1, 0), cA + kstep, voffA); PG8_STAGE(PG8_SB(1, 1), cB + hstepB + kstep, voffB);
    PG8_WAIT_V(6); PG8_BAR;
    for (;;) {
        const bool has_next = S.next(ui + 1, nxt);
        const char* nA = has_next ? nxt.A : cA; const char* nB = has_next ? nxt.B : cB;
        for (int t = 0; t < nt; t += 2) {
            const bool last = (t == nt - 2);
            const char* a1 = cA + (size_t)(t + 1) * kstep;
            const char* a2 = last ? nA : cA + (size_t)(t + 2) * kstep; const char* b2 = last ? nB : cB + (size_t)(t + 2) * kstep;
            const char* a3 = a2 + kstep; const char* b3 = b2 + kstep;
            PG8_LDB(B0, 0, 0); PG8_LDB(B1, 0, 1); PG8_SCHED; PG8_LDA(At, 0, 0); PG8_STAGE(PG8_SA(1, 1), a1 + hstepA, voffA);
            PG8_WAIT_V(8); PG8_WAIT_L(0); PG8_BAR; PG8_MMA(0, 0, At, B0); PG8_MMA(0, 1, At, B1); PG8_BAR; PG8_SCHED;
            PG8_LDA(At, 0, 1); PG8_STAGE(PG8_SB(0, 0), b2, voffB); PG8_STAGE(PG8_SB(0, 1), b2 + hstepB, voffB); PG8_STAGE(PG8_SA(0, 0), a2, voffA);
            PG8_WAIT_V(8); PG8_WAIT_L(0); PG8_BAR; PG8_MMA(1, 0, At, B0); PG8_MMA(1, 1, At, B1); PG8_BAR; PG8_SCHED;
            PG8_LDB(B0, 1, 0); PG8_LDB(B1, 1, 1); PG8_SCHED; PG8_LDA(At, 1, 0); PG8_STAGE(PG8_SA(0, 1), a2 + hstepA, voffA);
            PG8_WAIT_V(8); PG8_WAIT_L(0); PG8_BAR; PG8_MMA(0, 0, At, B0); PG8_MMA(0, 1, At, B1); PG8_BAR; PG8_SCHED;
            PG8_LDA(At, 1, 1); PG8_STAGE(PG8_SB(1, 0), b3, voffB); PG8_STAGE(PG8_SB(1, 1), b3 + hstepB, voffB); PG8_STAGE(PG8_SA(1, 0), a3, voffA);
            PG8_WAIT_V(8); PG8_WAIT_L(0); PG8_BAR; PG8_MMA(1, 0, At, B0); PG8_MMA(1, 1, At, B1); PG8_BAR; PG8_SCHED;
        }
        if (align) { if (wr == 0) PG8_BAR; }
        { const int lx = lane_id(); if (F8) E.in8(acc, cur, wr, wc, lx & 15, lx >> 4); else E(acc, cur, wr, wc, lx & 15, lx >> 4); }
        if (!has_next) break;
        if (!(E.mode == EM_PAB && cur.ph == 0)) {
#pragma unroll
        for (int a = 0; a < 2; ++a)
#pragma unroll
            for (int b = 0; b < 2; ++b)
#pragma unroll
                for (int m = 0; m < 4; ++m)
#pragma unroll
                    for (int n = 0; n < 2; ++n) acc[a][b][m][n] = (f32x4){0.f, 0.f, 0.f, 0.f};
        }
        cur = nxt; cA = nA; cB = nB; ++ui;
        if (align) { if (wr == 1) PG8_BAR; }
    }
    PG8_WAIT_V(0);
    if (!align) { if (wr == 0) PG8_BAR; }
    PG8_BAR;
#undef PG8_SA
#undef PG8_SB
#undef PG8_STAGE
#undef PG8_LDA
#undef PG8_LDB
#undef PG8_MMA
#undef PG8_WAIT_V
#undef PG8_WAIT_L
#undef PG8_BAR
#undef PG8_SCHED
}
}

#define XB_TMO      128
#define XB_XCNT(j)  (256  + 64 * (j))
#define XB_XSUB(j)  (1280 + 64 * (j))
#define XB_XGEN(j)  (2304 + 64 * (j))
#define XB_TOP      3328
#define XB_TOPGEN   3392
#define XCD_BAR_WORDS 3456
#define XB_SPIN_CAP (1u << 18)
__device__ __forceinline__ unsigned xb_ld(unsigned* p)              { return __hip_atomic_load(p, __ATOMIC_RELAXED, __HIP_MEMORY_SCOPE_AGENT); }
__device__ __forceinline__ unsigned xb_add(unsigned* p, unsigned v) { return __hip_atomic_fetch_add(p, v, __ATOMIC_RELAXED, __HIP_MEMORY_SCOPE_AGENT); }
__device__ __forceinline__ unsigned xb_xcc_id() { return (unsigned)__builtin_amdgcn_s_getreg((3 << 11) | 20) & 0xFu; }
#define XB_SPIN(cond, bar) do { unsigned _sp = 0; while (cond) { __builtin_amdgcn_s_sleep(1); \
    if ((++_sp & 255u) == 0u) { if (xb_ld(&(bar)[XB_TMO])) break; if (_sp > XB_SPIN_CAP) { atomicAdd(&(bar)[XB_TMO], 1u); break; } } } } while (0)
struct XcdBarrier { unsigned* bar; unsigned x; volatile LAS unsigned* st; };
__device__ __forceinline__ XcdBarrier xcd_barrier_post(unsigned* bar, volatile LAS unsigned* st, bool lead) {
    XcdBarrier b; b.bar = bar; b.x = xb_xcc_id(); b.st = st;
    if (lead) (void)xb_add(&bar[XB_XCNT(b.x)], 1u);
    return b;
}
__device__ __forceinline__ void xcd_barrier_complete(unsigned* bar, unsigned x, unsigned& nloc, unsigned& nx) {
    const unsigned G = gridDim.x * gridDim.y * gridDim.z;
    unsigned sum, cnt, mine, sp = 0u;
    for (;;) {
        sum = 0u; cnt = 0u; mine = 0u;
#pragma unroll
        for (unsigned j = 0; j < 16; ++j) { const unsigned c = xb_ld(&bar[XB_XCNT(j)]); sum += c; cnt += (c > 0u) ? 1u : 0u; mine = (j == x) ? c : mine; }
        if (sum == G) break;
        __builtin_amdgcn_s_sleep(1);
        if ((++sp & 255u) == 0u) { if (xb_ld(&bar[XB_TMO])) break; if (sp > XB_SPIN_CAP) { atomicAdd(&bar[XB_TMO], 1u); break; } }
    }
    nloc = mine > 0u ? mine : 1u; nx = cnt > 0u ? cnt : 1u;
}
__device__ __forceinline__ void xcd_barrier(const XcdBarrier& b, bool lead) {
    asm volatile("s_waitcnt vmcnt(0)" ::: "memory");
    __syncthreads();
    if (lead) {
        unsigned* bar = b.bar;
        __builtin_amdgcn_s_waitcnt(0);
        unsigned nloc = b.st[0], nx = b.st[1];
        if (nloc == 0u) { xcd_barrier_complete(bar, b.x, nloc, nx); b.st[0] = nloc; b.st[1] = nx; }
        const unsigned old = xb_add(&bar[XB_XSUB(b.x)], 1u);
        const unsigned gen = old / nloc;
        if (old + 1u == (gen + 1u) * nloc) {
            __builtin_amdgcn_fence(__ATOMIC_RELEASE, "agent");
            asm volatile("s_waitcnt vmcnt(0)" ::: "memory");
            const unsigned og = xb_add(&bar[XB_TOP], 1u);
            const unsigned tg = og / nx;
            if (og + 1u == (tg + 1u) * nx) xb_add(&bar[XB_TOPGEN], 1u);
            else XB_SPIN(xb_ld(&bar[XB_TOPGEN]) == tg, bar);
            __builtin_amdgcn_fence(__ATOMIC_ACQUIRE, "agent");
            xb_add(&bar[XB_XGEN(b.x)], 1u);
            asm volatile("s_waitcnt vmcnt(0)" ::: "memory");
        } else {
            XB_SPIN(xb_ld(&bar[XB_XGEN(b.x)]) == gen, bar);
            __builtin_amdgcn_fence(__ATOMIC_ACQUIRE, "agent");
            asm volatile("s_waitcnt vmcnt(0)" ::: "memory");
        }
    }
    __syncthreads();
}

struct Frame {
    LAS unsigned char* lds;
    int tid, lane, wave, G, bx;
    unsigned char* ws;
};

__device__ __forceinline__ void big_gemm(Frame& F, const Params& p, int mode, const void* A, int lda, const void* B, int ldb, int M, int N, int K) {
    pg8::Sched S; S.A = (const char*)A; S.B = (const char*)B; S.gA = 0; S.gB = 0; S.lda = lda; S.ldb = ldb; S.nM = M / 256; S.nN = N / 256; S.nG = 1; S.G = F.G; S.c = F.bx; S.A2 = S.A; S.B2 = S.B; S.pair = 0; S.esz = 2;
    pg8::Epi E; E.mode = mode; E.ws = F.ws; E.x = p.in[0]; E.out = p.out; E.modf = (const float*)(F.ws + WS_MODF);
    pg8::gemm_phase(F.lds, K, S, E, F.wave);
}

__device__ __forceinline__ void p0_transpose_item(const float* W, int K, int N, bf16* WT, LAS float* scr, int item, int lane, bool gatemix = false) {
    const int nblk = N / 32, kb = item / nblk, nb = item % nblk, k0 = 64 * kb, n0 = 32 * nb;
    int nd0 = n0;
    if (gatemix && n0 >= 3072) { const int a = (n0 - 3072) >> 11, d = (n0 - 3072) & 2047; nd0 = 3072 + (d >> 7) * 256 + a * 128 + (d & 127); }
#pragma unroll 8
    for (int i = 0; i < 32; ++i) { const int kk = 2 * i + (lane >> 5); scr[kk * 33 + (lane & 31)] = W[(size_t)(k0 + kk) * N + n0 + (lane & 31)]; }
    LDS_WAIT(); asm volatile("" ::: "memory");
    const int c = lane & 7;
#pragma unroll
    for (int j = 0; j < 4; ++j) { const int n = (lane >> 3) + 8 * j; const LAS float* s = scr + (8 * c) * 33 + n;
        u32x4 o; o.x = pk2(s[0 * 33], s[1 * 33]); o.y = pk2(s[2 * 33], s[3 * 33]); o.z = pk2(s[4 * 33], s[5 * 33]); o.w = pk2(s[6 * 33], s[7 * 33]);
        *(u32x4*)(WT + (size_t)(nd0 + n) * K + k0 + 8 * c) = o; }
    LDS_WAIT(); asm volatile("" ::: "memory");
}

__device__ __forceinline__ void p0_mod_item(Frame& F, const Params& p, int item) {
    constexpr int KS = D / KSL;
    LAS float* sv = (LAS float*)F.lds;
    const int ks = item / 6, cb = item % 6, k0 = ks * KS;
    __syncthreads();
    for (int i = F.tid; i < 3 * KS; i += NTHREADS) { const int r = i / KS, k = i % KS; const float c = (r < 2) ? p.in[1][r * D + k0 + k] : p.in[3][k0 + k]; sv[i] = c / (1.f + __expf(-c)); }
    __syncthreads();
    const int col = cb * 2048 + F.tid * 4;
    const float* W = p.in[4] + (size_t)k0 * 12288 + col;
    f32x4 a0 = {0, 0, 0, 0}, a1 = a0, a2 = a0;
#pragma unroll 16
    for (int k = 0; k < KS; ++k) { const f32x4 w = *(const f32x4*)(W + (size_t)k * 12288); a0 += w * sv[k]; a1 += w * sv[KS + k]; a2 += w * sv[2 * KS + k]; }
    float* o = (float*)(F.ws + WS_MODP) + (size_t)ks * 3 * 12288 + col;
    *(f32x4*)o = a0; *(f32x4*)(o + 12288) = a1; *(f32x4*)(o + 2 * 12288) = a2;
}

__device__ __forceinline__ void p0_s5_tables(Frame& F, const Params& p, int g, int half) {
    typedef float f2 __attribute__((ext_vector_type(2)));
    LAS f2* pw = (LAS f2*)F.lds;
    LAS f2* Bb = (LAS f2*)(F.lds + 34560);
    LAS f2* Cc = (LAS f2*)(F.lds + 34560 + 16384);
    LAS float* Kt = (LAS float*)(F.lds + 34560 + 16384 + 16640);
    const float* a_re = p.in[8]; const float* a_im = p.in[9]; const float* log_dt = p.in[10];
    const float* b_re = p.in[11]; const float* b_im = p.in[12]; const float* c_re = p.in[13]; const float* c_im = p.in[14]; const float* dsk = p.in[15];
    __syncthreads();
    if (F.tid < 128) {
        const int d = F.tid >> 6, pp = F.tid & 63;
        const float lr = a_re[(d * 64 + g) * 64 + pp], li = a_im[(d * 64 + g) * 64 + pp], dt = __expf(log_dt[d * 64 + g]);
        {
            const float mag1 = expf(dt * lr); float sn1, cs1; sincosf(dt * li, &sn1, &cs1); const float ar = mag1 * cs1, ai = mag1 * sn1; float wr = 1.f, wi = 0.f;
            for (int tau = 0; tau <= 32; ++tau) { pw[(d * 33 + tau) * 65 + pp] = (f2){wr, wi}; const float nr = wr * ar - wi * ai; wi = wr * ai + wi * ar; wr = nr; }
        }
        const float x = dt * lr, y = dt * li; float sn, cs, sh, ch; sincosf(y, &sn, &cs); sincosf(0.5f * y, &sh, &ch);
        const float em = expm1f(x), nr = em * cs - 2.f * sh * sh, ni = (em + 1.f) * sn;
        const float den = lr * lr + li * li, qr = (nr * lr + ni * li) / den, qi = (ni * lr - nr * li) / den;
        for (int h = 0; h < 16; ++h) { const float br = b_re[((d * 64 + g) * 64 + pp) * 16 + h], bi = b_im[((d * 64 + g) * 64 + pp) * 16 + h]; Bb[(d * 64 + pp) * 16 + h] = (f2){qr * br - qi * bi, qr * bi + qi * br}; }
        for (int h = 0; h < 16; ++h) Cc[(d * 16 + h) * 65 + pp] = (f2){c_re[((d * 64 + g) * 16 + h) * 64 + pp], c_im[((d * 64 + g) * 16 + h) * 64 + pp]};
    }
    __syncthreads();
    {
        const int d = F.tid >> 8, tau = (F.tid >> 3) & 31, hp0 = (F.tid & 7) * 2;
        for (int hh = 0; hh < 2; ++hh) {
            const int hp = hp0 + hh; float accv[16];
#pragma unroll
            for (int h = 0; h < 16; ++h) accv[h] = 0.f;
            for (int pp = 0; pp < 64; ++pp) {
                const f2 c = Cc[(d * 16 + hp) * 65 + pp], w = pw[(d * 33 + tau) * 65 + pp]; const float wr = c.x * w.x - c.y * w.y, wi = c.x * w.y + c.y * w.x;
#pragma unroll
                for (int h = 0; h < 16; ++h) { const f2 b = Bb[(d * 64 + pp) * 16 + h]; accv[h] += wr * b.x - wi * b.y; }
            }
#pragma unroll
            for (int h = 0; h < 16; ++h) Kt[((d * 32 + tau) * 16 + hp) * 16 + h] = accv[h];
        }
    }
    __syncthreads();
    bf16* MF = (bf16*)(F.ws + WS_MFULL) + (size_t)g * 512 * XK;
    for (int c = half * 256 * 96 + F.tid; c < (half + 1) * 256 * 96; c += NTHREADS) {
        const int row = c / 96, kc = (c % 96) * 8, j = row >> 4, hp = row & 15; float v[8];
        if (kc < 512) {
            const int s = kc >> 4, h0 = kc & 15;
#pragma unroll
            for (int e = 0; e < 8; ++e) { const int h = h0 + e; float val;
                if (j > s) val = Kt[((0 * 32 + (j - s)) * 16 + hp) * 16 + h];
                else if (s > j) val = Kt[((1 * 32 + (s - j)) * 16 + hp) * 16 + h];
                else val = Kt[((0 * 32 + 0) * 16 + hp) * 16 + h] + Kt[((1 * 32 + 0) * 16 + hp) * 16 + h] + (h == hp ? dsk[g * 16 + h] : 0.f);
                v[e] = val; }
        } else {
            const int kk = kc - 512, blk = kk >> 6, p0 = kk & 63, d = blk >> 1, tau = d ? (32 - j) : (j + 1);
#pragma unroll
            for (int e = 0; e < 8; ++e) { const f2 c2 = Cc[(d * 16 + hp) * 65 + p0 + e], w = pw[(d * 33 + tau) * 65 + p0 + e];
                v[e] = (blk & 1) ? -(c2.x * w.y + c2.y * w.x) : (c2.x * w.x - c2.y * w.y); }
        }
        u32x4 o; o.x = pk2(v[0], v[1]); o.y = pk2(v[2], v[3]); o.z = pk2(v[4], v[5]); o.w = pk2(v[6], v[7]);
        *(u32x4*)(MF + (size_t)row * XK + kc) = o;
    }
    bf16* MS = (bf16*)(F.ws + WS_MS) + (size_t)g * 256 * 512;
    for (int c = half * 128 * 64 + F.tid; c < (half + 1) * 128 * 64; c += NTHREADS) {
        const int row = c >> 6, kc = (c & 63) * 8, s = kc >> 4, h0 = kc & 15, blk = row >> 6, pp = row & 63, d = blk >> 1, tau = d ? s : (31 - s);
        const f2 w = pw[(d * 33 + tau) * 65 + pp]; float v[8];
#pragma unroll
        for (int e = 0; e < 8; ++e) { const f2 b = Bb[(d * 64 + pp) * 16 + h0 + e]; v[e] = (blk & 1) ? (w.x * b.y + w.y * b.x) : (w.x * b.x - w.y * b.y); }
        u32x4 o; o.x = pk2(v[0], v[1]); o.y = pk2(v[2], v[3]); o.z = pk2(v[4], v[5]); o.w = pk2(v[6], v[7]);
        *(u32x4*)(MS + (size_t)row * 512 + kc) = o;
    }
    __syncthreads();
}

__device__ __forceinline__ void phase0a(Frame& F, const Params& p, const int parts = 7) {
    if (parts & 1) { if (F.bx < 6 * KSL) p0_mod_item(F, p, F.bx);
    else if (F.bx >= 128) p0_s5_tables(F, p, (F.bx - 128) >> 1, (F.bx - 128) & 1); }
    __syncthreads();
    LAS float* scr = (LAS float*)(F.lds + F.wave * 16384);
    const int gw = F.bx * NWAVES + F.wave, NGW = F.G * NWAVES;
    const bool freeb = (F.bx >= 6 * KSL) && (F.bx < 128);
    const int fw = (F.bx - 6 * KSL) * NWAVES + F.wave, NFW = (128 - 6 * KSL) * NWAVES;
    constexpr int I_IN = (D / 64) * (INW / 32), I_GLU = (S5W / 64) * (S5W / 32), I_PA = (S5W / 64) * (D / 32), I_PB = I_PA, I_OUT = (D / 64) * (D / 32), I_Q = I_OUT;
    constexpr int NT1 = I_IN + I_GLU + I_PA + I_PB + I_OUT + I_Q, NT1F = (NT1 * 3 / 20 / 8) * 8;
    if (parts & 2) for (int stage = 0; stage < 2; ++stage) {
        if (stage == 0 && !freeb) continue;
        const int beg = stage == 0 ? fw : NT1F + gw, end = stage == 0 ? NT1F : NT1, step = stage == 0 ? NFW : NGW;
        for (int it = beg; it < end; it += step) {
            int r = it;
            if (r < I_IN) { p0_transpose_item(p.in[7], D, INW, (bf16*)(F.ws + WS_WIN), scr, r, F.lane, true); continue; } r -= I_IN;
            if (r < I_GLU) { p0_transpose_item(p.in[16], S5W, S5W, (bf16*)(F.ws + WS_WGLU), scr, r, F.lane); continue; } r -= I_GLU;
            if (r < I_PA) { p0_transpose_item(p.in[24], S5W, D, (bf16*)(F.ws + WS_WPA), scr, r, F.lane); continue; } r -= I_PA;
            if (r < I_PB) { p0_transpose_item(p.in[25], LRUW, D, (bf16*)(F.ws + WS_WPB), scr, r, F.lane); continue; } r -= I_PB;
            if (r < I_OUT) { p0_transpose_item(p.in[26], D, D, (bf16*)(F.ws + WS_WOUT), scr, r, F.lane); continue; } r -= I_OUT;
            p0_transpose_item(p.in[28], D, D, (bf16*)(F.ws + WS_WQ), scr, r, F.lane);
        }
    }
    constexpr int NT2 = 2 * 16384, NT2F = (NT2 * 3 / 20 / 8) * 8;
    if (parts & 4) for (int stage = 0; stage < 2; ++stage) {
        if (stage == 0 && !freeb) continue;
        const int beg = stage == 0 ? fw : NT2F + gw, end = stage == 0 ? NT2F : NT2, step = stage == 0 ? NFW : NGW;
        for (int it = beg; it < end; it += step) {
            const int which = it >> 14, row = it & 16383;
            const f32x4* src = (const f32x4*)(p.in[30 + which] + (size_t)row * D) + F.lane;
            f32x4 v[8];
#pragma unroll
            for (int j = 0; j < 8; ++j) v[j] = src[64 * j];
            {
                float ssq = 0.f;
#pragma unroll
                for (int j = 0; j < 8; ++j) ssq += (v[j][0] * v[j][0] + v[j][1] * v[j][1]) + (v[j][2] * v[j][2] + v[j][3] * v[j][3]);
                ssq = wave_sum(ssq, F.lane);
                const float stepq = 0.3352f * sqrtf(ssq * (1.f / D)), invs = stepq > 0.f ? 1.f / stepq : 0.f;
                unsigned char* dst4 = F.ws + (which ? WS_PV : WS_PU);
                const int nadd = (F.lane & 1) ? 16 : 8;
#pragma unroll
                for (int j = 0; j < 8; ++j) {
                    unsigned nib = 0;
#pragma unroll
                    for (int i = 0; i < 4; ++i) { int q = (int)floorf(v[j][i] * invs); q = q < -8 ? -8 : (q > 7 ? 7 : q); nib |= (unsigned)((q + nadd) & 15) << (8 * i); }
                    const unsigned other = (unsigned)__builtin_amdgcn_update_dpp(0, (int)nib, 0xB1, 0xF, 0xF, false);
                    if (!(F.lane & 1)) *(unsigned*)(dst4 + ((size_t)j * 16384 + row) * 128 + (F.lane >> 1) * 4) = nib | (other << 4);
                }
                if (F.lane == 0) ((float*)(F.ws + (which ? WS_SV : WS_SU)))[row] = stepq;
            }
        }
    }
    const int gt = F.bx * NTHREADS + F.tid, NGT = F.G * NTHREADS;
    for (int i = gt; i < 2 * 128 * 128; i += NGT) ((bf16*)(F.ws + WS_SKB))[i] = (bf16)f2bf(p.in[29][i]);
    for (int i = gt; i < 2 * 16 * 2 * 64 * 64; i += NGT) {
        const int ii = i & 63, j = (i >> 6) & 63, gate = (i >> 12) & 1, h = (i >> 13) & 15, d = i >> 17;
        const float* w = gate ? p.in[22] : p.in[20];
        ((bf16*)(F.ws + WS_LW))[i] = (bf16)f2bf(-1.4426950408889634f * w[((size_t)(d * 16 + h) * 64 + ii) * 64 + j]);
    }
}

__device__ __forceinline__ void phase_norm(Frame& F, const Params& p, int which) {
    LAS float* gs = (LAS float*)F.lds;
    LAS float* sh = (LAS float*)(F.lds + 3 * D * 4);
    const float* modp = (const float*)(F.ws + WS_MODP); float* modf = (float*)(F.ws + WS_MODF);
    const float* bada = p.in[5];
    __syncthreads();
    if (which == 0) {
        for (int i = F.tid; i < 3 * D; i += NTHREADS) {
            const int r = i / D, k = i % D; float s0 = bada[k], s1 = bada[D + k];
            for (int ks = 0; ks < KSL; ++ks) { s0 += modp[(size_t)(ks * 3 + r) * 12288 + k]; s1 += modp[(size_t)(ks * 3 + r) * 12288 + D + k]; }
            gs[i] = p.in[6][k] * (1.f + s1); sh[i] = s0;
        }
        for (int i = F.bx * NTHREADS + F.tid; i < 3 * 12288; i += F.G * NTHREADS) {
            const int r = i / 12288, c = i % 12288; float s = bada[c];
            for (int ks = 0; ks < KSL; ++ks) s += modp[(size_t)(ks * 3 + r) * 12288 + c];
            modf[i] = s;
        }
    } else {
        for (int i = F.tid; i < 2 * D; i += NTHREADS) { const int r = i / D, k = i % D; gs[i] = p.in[27][k] * (1.f + modf[r * 12288 + 4 * D + k]); sh[i] = modf[r * 12288 + 3 * D + k]; }
    }
    __syncthreads();
    const int gw = F.bx * NWAVES + F.wave, NGW = F.G * NWAVES;
    const int nrows = which == 0 ? NTOK + NCTXT : NTOK;
    for (int m = gw; m < nrows; m += NGW) {
        const float* xrow; bf16* orow; int r;
        if (which == 0) {
            if (m < NTOK) { xrow = p.in[0] + (size_t)m * D; orow = (bf16*)(F.ws + WS_NBUF) + (size_t)m * D; r = m >> 14; }
            else { xrow = p.in[2] + (size_t)(m - NTOK) * D; orow = (bf16*)(F.ws + WS_NCTX) + (size_t)(m - NTOK) * D; r = 2; }
        } else { xrow = p.in[0] + (size_t)m * D; orow = (bf16*)(F.ws + WS_NBUF) + (size_t)m * D; r = m >> 14; }
        const f32x4* xr = (const f32x4*)xrow + F.lane;
        f32x4 v[8]; float s = 0.f;
        if (which == 1) {
            const u32x2* mr = (const u32x2*)((const bf16*)(F.ws + WS_MIX) + (size_t)m * D) + F.lane;
#pragma unroll
            for (int j = 0; j < 8; ++j) { const u32x2 mw = mr[64 * j]; v[j] = (f32x4){bf_lo(mw.x), bf_hi(mw.x), bf_lo(mw.y), bf_hi(mw.y)}; }
        } else {
#pragma unroll
            for (int j = 0; j < 8; ++j) v[j] = xr[64 * j];
        }
#pragma unroll
        for (int j = 0; j < 8; ++j) s += (v[j][0] * v[j][0] + v[j][1] * v[j][1]) + (v[j][2] * v[j][2] + v[j][3] * v[j][3]);
        const float rstd = rsqrtf(wave_sum(s, F.lane) * (1.f / D) + 1e-6f);
        u32x2* o8 = (u32x2*)orow + F.lane;
        float am = 0.f;
#pragma unroll
        for (int j = 0; j < 8; ++j) {
            const f32x4 g4 = *(const LAS f32x4*)(gs + r * D + 4 * F.lane + 256 * j), s4 = *(const LAS f32x4*)(sh + r * D + 4 * F.lane + 256 * j);
            v[j] = (f32x4){v[j][0] * rstd * g4[0] + s4[0], v[j][1] * rstd * g4[1] + s4[1], v[j][2] * rstd * g4[2] + s4[2], v[j][3] * rstd * g4[3] + s4[3]};
            if (!(which == 0 && m < NTOK)) { u32x2 o; o.x = pk2(v[j][0], v[j][1]); o.y = pk2(v[j][2], v[j][3]); o8[64 * j] = o; }
            am = fmaxf(am, fmaxf(fmaxf(fabsf(v[j][0]), fabsf(v[j][1])), fmaxf(fabsf(v[j][2]), fabsf(v[j][3]))));
        }
        if (which == 0 && m < NTOK) {
#pragma unroll
            for (int o = 1; o < 64; o <<= 1) am = fmaxf(am, shx(am, o, F.lane));
            const float inv = am > 0.f ? 127.f / am : 0.f;
            unsigned* nq = (unsigned*)(F.ws + WS_NBUF8 + (size_t)m * D) + F.lane;
#pragma unroll
            for (int j = 0; j < 8; ++j) {
                const int q0 = (int)rintf(v[j][0] * inv), q1 = (int)rintf(v[j][1] * inv), q2 = (int)rintf(v[j][2] * inv), q3 = (int)rintf(v[j][3] * inv);
                nq[64 * j] = (unsigned)(q0 & 255) | ((unsigned)(q1 & 255) << 8) | ((unsigned)(q2 & 255) << 16) | ((unsigned)(q3 & 255) << 24);
            }
            if (F.lane == 0) ((float*)(F.ws + WS_RS))[m] = am * (1.f / 127.f);
        }
        if (which == 1) {
#pragma unroll
            for (int o = 1; o < 64; o <<= 1) am = fmaxf(am, shx(am, o, F.lane));
            const float inv = am > 0.f ? 127.f / am : 0.f;
            unsigned* fq = (unsigned*)(F.ws + WS_FQ + (size_t)m * D) + F.lane;
            int qsum = 0;
#pragma unroll
            for (int j = 0; j < 8; ++j) {
                const int q0 = (int)rintf(v[j][0] * inv), q1 = (int)rintf(v[j][1] * inv), q2 = (int)rintf(v[j][2] * inv), q3 = (int)rintf(v[j][3] * inv);
                fq[64 * j] = (unsigned)(q0 & 255) | ((unsigned)(q1 & 255) << 8) | ((unsigned)(q2 & 255) << 16) | ((unsigned)(q3 & 255) << 24);
                qsum += (q0 + q1) + (q2 + q3);
            }
#pragma unroll
            for (int o = 2; o < 64; o <<= 1) qsum += shx(qsum, o, F.lane);
            if (F.lane == 0) ((float*)(F.ws + WS_FS))[m] = am * (1.f / 127.f);
            if (F.lane < 2) ((int*)(F.ws + WS_FS + (1u << 20)))[2 * m + F.lane] = qsum;
        }
    }
    if (which == 0) {
        for (int rw = gw; rw < INW; rw += NGW) {
            const u32x4* src = (const u32x4*)((const bf16*)(F.ws + WS_WIN) + (size_t)rw * D) + F.lane;
            u32x2* dst = (u32x2*)(F.ws + WS_WINI8 + (size_t)rw * D) + F.lane;
            u32x4 w[4]; float cm = 0.f;
#pragma unroll
            for (int j = 0; j < 4; ++j) {
                w[j] = src[64 * j];
                cm = fmaxf(cm, fmaxf(fmaxf(fmaxf(fabsf(bf_lo(w[j].x)), fabsf(bf_hi(w[j].x))), fmaxf(fabsf(bf_lo(w[j].y)), fabsf(bf_hi(w[j].y)))),
                                     fmaxf(fmaxf(fabsf(bf_lo(w[j].z)), fabsf(bf_hi(w[j].z))), fmaxf(fabsf(bf_lo(w[j].w)), fabsf(bf_hi(w[j].w))))));
            }
#pragma unroll
            for (int o = 1; o < 64; o <<= 1) cm = fmaxf(cm, shx(cm, o, F.lane));
            const float inv = cm > 0.f ? 127.f / cm : 0.f;
#pragma unroll
            for (int j = 0; j < 4; ++j) {
                const int q0 = (int)rintf(bf_lo(w[j].x) * inv), q1 = (int)rintf(bf_hi(w[j].x) * inv), q2 = (int)rintf(bf_lo(w[j].y) * inv), q3 = (int)rintf(bf_hi(w[j].y) * inv);
                const int q4 = (int)rintf(bf_lo(w[j].z) * inv), q5 = (int)rintf(bf_hi(w[j].z) * inv), q6 = (int)rintf(bf_lo(w[j].w) * inv), q7 = (int)rintf(bf_hi(w[j].w) * inv);
                u32x2 o; o.x = (unsigned)(q0 & 255) | ((unsigned)(q1 & 255) << 8) | ((unsigned)(q2 & 255) << 16) | ((unsigned)(q3 & 255) << 24);
                o.y = (unsigned)(q4 & 255) | ((unsigned)(q5 & 255) << 8) | ((unsigned)(q6 & 255) << 16) | ((unsigned)(q7 & 255) << 24);
                dst[64 * j] = o;
            }
            if (F.lane == 0) ((float*)(F.ws + WS_CMAX))[rw] = cm;
        }
    }
}

__device__ __forceinline__ void ctx_in_gemm(Frame& F) {
    const int w = F.bx * NWAVES + F.wave; if (w >= 2048) return;
    const int rt = w >> 6, ct = w & 63, l15 = F.lane & 15, q = F.lane >> 4;
    const bf16* A = (const bf16*)(F.ws + WS_NCTX) + (size_t)(rt * 16 + l15) * D + 8 * q;
    const bf16* B0 = (const bf16*)(F.ws + WS_WIN) + (size_t)(ct * 32 + l15) * D + 8 * q;
    const bf16* B1 = B0 + (size_t)16 * D;
    f32x4 a0 = {0, 0, 0, 0}, a1 = a0;
#pragma unroll 8
    for (int ks = 0; ks < 64; ++ks) {
        const bf16x8 a = *(const bf16x8*)(A + ks * 32), b0 = *(const bf16x8*)(B0 + ks * 32), b1 = *(const bf16x8*)(B1 + ks * 32);
        a0 = __builtin_amdgcn_mfma_f32_16x16x32_bf16(a, b0, a0, 0, 0, 0); a1 = __builtin_amdgcn_mfma_f32_16x16x32_bf16(a, b1, a1, 0, 0, 0);
    }
#pragma unroll
    for (int nn = 0; nn < 2; ++nn)
#pragma unroll
        for (int r = 0; r < 4; ++r) {
            const int tc = rt * 16 + 4 * q + r, c = ct * 32 + nn * 16 + l15; const float v = nn ? a1[r] : a0[r];
            if (c < 1024) ((bf16*)(F.ws + WS_XC))[((size_t)((c >> 4) * 16 + (tc >> 5)) * 512) + (tc & 31) * 16 + (c & 15)] = (bf16)f2bf(v);
            else ((bf16*)(F.ws + WS_VC))[(size_t)tc * LRUW + (c - 1024)] = (bf16)f2bf(v);
        }
}
__device__ __forceinline__ void ctx_s5_states(Frame& F) {
    const int w = F.bx * NWAVES + F.wave; if (w >= 1024) return;
    const int g = w >> 4, ctile = w & 15, l15 = F.lane & 15, q = F.lane >> 4;
    const bf16* A = (const bf16*)(F.ws + WS_XC) + (size_t)(g * 16 + l15) * 512 + 8 * q;
    const bf16* B = (const bf16*)(F.ws + WS_MS) + (size_t)(g * 256 + ctile * 16 + l15) * 512 + 8 * q;
    f32x4 a0 = {0, 0, 0, 0};
#pragma unroll
    for (int ks = 0; ks < 16; ++ks) a0 = __builtin_amdgcn_mfma_f32_16x16x32_bf16(*(const bf16x8*)(A + ks * 32), *(const bf16x8*)(B + ks * 32), a0, 0, 0, 0);
#pragma unroll
    for (int r = 0; r < 4; ++r) ((float*)(F.ws + WS_SC))[(size_t)(g * 16 + 4 * q + r) * 256 + ctile * 16 + l15] = a0[r];
}

constexpr int LRU_WROW = 72;
__device__ __forceinline__ float fast_sigmoid(float x) { return __builtin_amdgcn_rcpf(1.f + __expf(-x)); }
template <int PASS>
__device__ __forceinline__ void lru_item(Frame& F, const LAS bf16* lw, const LAS float* prm, const LAS float* cwl, LAS float* xs, int head, int item) {
    const int rc = item & 7, col = (item >> 3) % 65, b = (item >> 3) / 65;
    int lane = F.lane; asm volatile("" : "+v"(lane));
    const int t = lane & 31, hh = lane >> 5;
    const bf16* vbase; size_t rstride;
    if (col < 64) { vbase = (const bf16*)(F.ws + WS_V) + ((size_t)(b * SEQ + col) * LRUW + head * 64); rstride = (size_t)64 * LRUW; }
    else { vbase = (const bf16*)(F.ws + WS_VC) + ((size_t)(b * CTXL) * LRUW + head * 64); rstride = LRUW; }
    const int r0 = rc * 32, r = r0 + t;
    const int q = (col < 64) ? (8 + col * 8 + rc) : rc;
    u32x4 vw[4][4];
#pragma unroll
    for (int k = 0; k < 4; ++k) {
        const int rr = r - 1 + k; const bool ok = (rr >= 0) && (rr < 256);
        const bf16* vr = vbase + (size_t)(ok ? rr : r) * rstride;
#pragma unroll
        for (int ks = 0; ks < 4; ++ks) { u32x4 w = *(const u32x4*)(vr + 16 * ks + 8 * hh); if (!ok) w = (u32x4){0u, 0u, 0u, 0u}; vw[k][ks] = w; }
    }
    float lc[2][2]; u32x4 gq[4];
    const size_t tok = (size_t)b * SEQ + (size_t)r * 64 + col;
    if (PASS == 2) {
#pragma unroll
        for (int d = 0; d < 2; ++d)
#pragma unroll
            for (int ct = 0; ct < 2; ++ct) lc[d][ct] = ((const float*)(F.ws + WS_LC))[(size_t)((b * 2 + d) * NQ + q) * 1024 + head * 64 + t + 32 * ct];
    }
    float xa[4][8];
#pragma unroll
    for (int ks = 0; ks < 4; ++ks) {
        const int ch = 16 * ks + 8 * hh;
        const f32x4 b0 = *(const LAS f32x4*)(cwl + 4 * 64 + ch), b1 = *(const LAS f32x4*)(cwl + 4 * 64 + ch + 4);
#pragma unroll
        for (int j = 0; j < 4; ++j) { xa[ks][j] = b0[j]; xa[ks][4 + j] = b1[j]; }
    }
#pragma unroll
    for (int k = 0; k < 4; ++k)
#pragma unroll
        for (int ks = 0; ks < 4; ++ks) {
            const u32x4 w = vw[k][ks]; const int ch = 16 * ks + 8 * hh;
            const f32x4 c0 = *(const LAS f32x4*)(cwl + k * 64 + ch), c1 = *(const LAS f32x4*)(cwl + k * 64 + ch + 4);
            xa[ks][0] += c0[0] * bf_lo(w.x); xa[ks][1] += c0[1] * bf_hi(w.x); xa[ks][2] += c0[2] * bf_lo(w.y); xa[ks][3] += c0[3] * bf_hi(w.y);
            xa[ks][4] += c1[0] * bf_lo(w.z); xa[ks][5] += c1[1] * bf_hi(w.z); xa[ks][6] += c1[2] * bf_lo(w.w); xa[ks][7] += c1[3] * bf_hi(w.w);
        }
    bf16x8 af[4];
#pragma unroll
    for (int ks = 0; ks < 4; ++ks) {
        u32x4 w; w.x = cvt_pk_bf16(xa[ks][0], xa[ks][1]); w.y = cvt_pk_bf16(xa[ks][2], xa[ks][3]); w.z = cvt_pk_bf16(xa[ks][4], xa[ks][5]); w.w = cvt_pk_bf16(xa[ks][6], xa[ks][7]);
        af[ks] = __builtin_bit_cast(bf16x8, w);
        *(LAS f32x4*)(xs + t * 68 + 16 * ks + 8 * hh) = (f32x4){xa[ks][0], xa[ks][1], xa[ks][2], xa[ks][3]};
        *(LAS f32x4*)(xs + t * 68 + 16 * ks + 8 * hh + 4) = (f32x4){xa[ks][4], xa[ks][5], xa[ks][6], xa[ks][7]};
    }
    if (PASS == 2) {
#pragma unroll
        for (int ks = 0; ks < 4; ++ks) gq[ks] = *(const u32x4*)((const bf16*)(F.ws + WS_GG) + tok * LRUW + head * 64 + 16 * ks + 8 * hh);
    }
    LDS_WAIT(); asm volatile("" ::: "memory");
    float xd[2][16];
#pragma unroll
    for (int ct = 0; ct < 2; ++ct)
#pragma unroll
        for (int rg = 0; rg < 16; ++rg) xd[ct][rg] = xs[((rg & 3) + 8 * (rg >> 2) + 4 * hh) * 68 + t + 32 * ct];
    float ysum[2][16];
#pragma unroll
    for (int d = 0; d < 2; ++d) {
#pragma unroll
        for (int ct = 0; ct < 2; ++ct) {
            f32x16 acc[2];
#pragma unroll
            for (int gt = 0; gt < 2; ++gt) {
                f32x16 a; for (int i = 0; i < 16; ++i) a[i] = 0.f;
                const LAS bf16* wb = lw + ((d * 2 + gt) * 64 + t + 32 * ct) * LRU_WROW + 8 * hh;
#pragma unroll
                for (int ks = 0; ks < 4; ++ks) a = __builtin_amdgcn_mfma_f32_32x32x16_bf16(af[ks], *(const LAS bf16x8*)(wb + 16 * ks), a, 0, 0, 0);
                acc[gt] = a;
            }
            const int chl = t + 32 * ct, ch = head * 64 + chl;
            float av[16], bv[16];
            {
                const float br = prm[(d * 3 + 0) * 64 + chl], bi = prm[(d * 3 + 1) * 64 + chl], c8 = prm[(d * 3 + 2) * 64 + chl];
#pragma unroll
                for (int rg = 0; rg < 16; ++rg) {
                    const float rr = __builtin_amdgcn_rcpf(1.f + __builtin_amdgcn_exp2f(acc[0][rg] + br)), ii = __builtin_amdgcn_rcpf(1.f + __builtin_amdgcn_exp2f(acc[1][rg] + bi));
                    const float a = __builtin_amdgcn_exp2f(c8 * rr), om = fmaf(-a, a, 1.f);
                    av[rg] = a; bv[rg] = __builtin_amdgcn_sqrtf(fmaxf(om, 0.f)) * (ii * xd[ct][rg]);
                }
            }
            float hl[16], cp[16], sA[4], sB[4];
#pragma unroll
            for (int q4 = 0; q4 < 4; ++q4) {
                if (d == 0) {
                    hl[4 * q4] = bv[4 * q4]; cp[4 * q4] = av[4 * q4];
#pragma unroll
                    for (int i = 1; i < 4; ++i) { hl[4 * q4 + i] = av[4 * q4 + i] * hl[4 * q4 + i - 1] + bv[4 * q4 + i]; cp[4 * q4 + i] = av[4 * q4 + i] * cp[4 * q4 + i - 1]; }
                    sA[q4] = cp[4 * q4 + 3]; sB[q4] = hl[4 * q4 + 3];
                } else {
                    hl[4 * q4 + 3] = bv[4 * q4 + 3]; cp[4 * q4 + 3] = av[4 * q4 + 3];
#pragma unroll
                    for (int i = 2; i >= 0; --i) { hl[4 * q4 + i] = av[4 * q4 + i] * hl[4 * q4 + i + 1] + bv[4 * q4 + i]; cp[4 * q4 + i] = av[4 * q4 + i] * cp[4 * q4 + i + 1]; }
                    sA[q4] = cp[4 * q4]; sB[q4] = hl[4 * q4];
                }
            }
            float Ae[4], Be[4], Ao[4], Bo[4];
#pragma unroll
            for (int q4 = 0; q4 < 4; ++q4) {
                const float oA = shx(sA[q4], 32, lane), oB = shx(sB[q4], 32, lane);
                Ae[q4] = hh ? oA : sA[q4]; Be[q4] = hh ? oB : sB[q4]; Ao[q4] = hh ? sA[q4] : oA; Bo[q4] = hh ? sB[q4] : oB;
            }
            if (PASS == 1) {
                float c = 0.f, P = 1.f;
                if (d == 0) {
#pragma unroll
                    for (int q4 = 0; q4 < 4; ++q4) { c = Ae[q4] * c + Be[q4]; c = Ao[q4] * c + Bo[q4]; P *= Ae[q4] * Ao[q4]; } }
                else {
#pragma unroll
                    for (int q4 = 3; q4 >= 0; --q4) { c = Ao[q4] * c + Bo[q4]; c = Ae[q4] * c + Be[q4]; P *= Ae[q4] * Ao[q4]; } }
                if (hh == 0) { float* o = (float*)(F.ws + WS_PL) + ((size_t)((b * 2 + d) * NQ + q) * 1024 + ch) * 2; o[0] = P; o[1] = c; }
            } else {
                float cin[4];
                float c = lc[d][ct];
                if (d == 0) {
#pragma unroll
                    for (int q4 = 0; q4 < 4; ++q4) { const float c0 = c; c = Ae[q4] * c + Be[q4]; const float c1 = c; c = Ao[q4] * c + Bo[q4]; cin[q4] = hh ? c1 : c0; } }
                else {
#pragma unroll
                    for (int q4 = 3; q4 >= 0; --q4) { const float c0 = c; c = Ao[q4] * c + Bo[q4]; const float c1 = c; c = Ae[q4] * c + Be[q4]; cin[q4] = hh ? c0 : c1; } }
#pragma unroll
                for (int rg = 0; rg < 16; ++rg) { const float hv = hl[rg] + cp[rg] * cin[rg >> 2]; if (d == 0) ysum[ct][rg] = hv; else ysum[ct][rg] += hv; }
            }
        }
    }
    if (PASS == 2) {
#pragma unroll
        for (int ct = 0; ct < 2; ++ct)
#pragma unroll
            for (int rg = 0; rg < 16; ++rg) xs[((rg & 3) + 8 * (rg >> 2) + 4 * hh) * 68 + t + 32 * ct] = ysum[ct][rg];
        LDS_WAIT(); asm volatile("" ::: "memory");
        bf16* yb = (bf16*)(F.ws + WS_YB) + tok * LRUW + head * 64;
#pragma unroll
        for (int ks = 0; ks < 4; ++ks) {
            const int c0 = 16 * ks + 8 * hh; const u32x4 g4 = gq[ks];
            const f32x4 y0 = *(const LAS f32x4*)(xs + t * 68 + c0), y1 = *(const LAS f32x4*)(xs + t * 68 + c0 + 4);
            u32x4 o; o.x = cvt_pk_bf16(y0[0] * bf_lo(g4.x), y0[1] * bf_hi(g4.x)); o.y = cvt_pk_bf16(y0[2] * bf_lo(g4.y), y0[3] * bf_hi(g4.y));
            o.z = cvt_pk_bf16(y1[0] * bf_lo(g4.z), y1[1] * bf_hi(g4.z)); o.w = cvt_pk_bf16(y1[2] * bf_lo(g4.w), y1[3] * bf_hi(g4.w));
            *(u32x4*)(yb + c0) = o;
        }
    }
    LDS_WAIT(); asm volatile("" ::: "memory");
}

template <int PASS>
__device__ __forceinline__ void lru_phase(Frame& F, const Params& p) {
    LAS bf16* lw = (LAS bf16*)F.lds;
    LAS float* prm = (LAS float*)(F.lds + 36864);
    LAS float* cwl = (LAS float*)(F.lds + 36864 + 1536);
    LAS float* xs = (LAS float*)(F.lds + 40960 + F.wave * (32 * 68 * 4));
    const int head = F.bx & 15;
    __syncthreads();
    for (int i = F.tid; i < 4 * 64 * 8; i += NTHREADS) {
        const int c = i & 7, j = (i >> 3) & 63, m = i >> 9, d = m >> 1, gt = m & 1;
        const u32x4 w = *(const u32x4*)((const bf16*)(F.ws + WS_LW) + ((size_t)(((d * 16 + head) * 2 + gt) * 64 + j) * 64 + 8 * c));
        *(LAS u32x4*)(lw + (m * 64 + j) * LRU_WROW + 8 * c) = w;
    }
    for (int i = F.tid; i < 2 * 64; i += NTHREADS) {
        const int d = i >> 6, c = i & 63, ch = head * 64 + c; const float lam = p.in[19][d * LRUW + ch];
        prm[(d * 3 + 0) * 64 + c] = -1.4426950408889634f * p.in[21][d * LRUW + ch]; prm[(d * 3 + 1) * 64 + c] = -1.4426950408889634f * p.in[23][d * LRUW + ch];
        prm[(d * 3 + 2) * 64 + c] = 1.4426950408889634f * -8.f * (lam > 15.f ? __expf(-lam) : log1pf(__expf(-lam)));
    }
    for (int i = F.tid; i < 5 * 64; i += NTHREADS) { const int k = i >> 6, c = i & 63; cwl[i] = (k < 4) ? p.in[17][k * LRUW + head * 64 + c] : p.in[18][head * 64 + c]; }
    __syncthreads();
    const int wg = (F.bx >> 4) * NWAVES + F.wave, NWG = (F.G >> 4) * NWAVES;
    const int nitems = 2 * 65 * 8;
    for (int it = wg; it < nitems; it += NWG) {
        if (PASS == 2 && ((it >> 3) % 65) == 64) continue;
        lru_item<PASS>(F, lw, prm, cwl, xs, head, it);
    }
    __syncthreads();
}

__device__ __forceinline__ void phase_carry(Frame& F, const Params& p) {
    if (F.bx < 32) {
        const int id = F.bx * NTHREADS + F.tid, pp = id & 63, d = (id >> 6) & 1, g = (id >> 7) & 63, b = id >> 13;
        const float lr = p.in[8][(d * 64 + g) * 64 + pp], li = p.in[9][(d * 64 + g) * 64 + pp], dt = __expf(p.in[10][d * 64 + g]);
        const float mag = expf(32.f * dt * lr); float sn, cs; sincosf(32.f * dt * li, &sn, &cs); const float ar = mag * cs, ai = mag * sn;
        const float* SC = (const float*)(F.ws + WS_SC) + (size_t)(g * 16 + b * 8) * 256 + d * 128 + pp;
        const float* SB = (const float*)(F.ws + WS_SBUF) + (size_t)(g * NCHUNK + b * 512) * 256 + d * 128 + pp;
        bf16* X = (bf16*)(F.ws + WS_X) + (size_t)(g * NCHUNK + b * 512) * XK + 512 + d * 128 + pp;
        float hr = 0.f, hi = 0.f;
        if (d == 0) {
            for (int c = 0; c < 8; ++c) { const float sr = SC[c * 256], si = SC[c * 256 + 64]; const float nr = ar * hr - ai * hi + sr; hi = ar * hi + ai * hr + si; hr = nr; }
            for (int n0 = 0; n0 < 512; n0 += 8) {
                float sr[8], si[8];
#pragma unroll
                for (int u = 0; u < 8; ++u) { sr[u] = SB[(size_t)(n0 + u) * 256]; si[u] = SB[(size_t)(n0 + u) * 256 + 64]; }
#pragma unroll
                for (int u = 0; u < 8; ++u) { X[(size_t)(n0 + u) * XK] = (bf16)f2bf(hr); X[(size_t)(n0 + u) * XK + 64] = (bf16)f2bf(hi);
                    const float nr = ar * hr - ai * hi + sr[u]; hi = ar * hi + ai * hr + si[u]; hr = nr; }
            }
        } else {
            for (int c = 7; c >= 0; --c) { const float sr = SC[c * 256], si = SC[c * 256 + 64]; const float nr = ar * hr - ai * hi + sr; hi = ar * hi + ai * hr + si; hr = nr; }
            for (int n0 = 504; n0 >= 0; n0 -= 8) {
                float sr[8], si[8];
#pragma unroll
                for (int u = 0; u < 8; ++u) { sr[u] = SB[(size_t)(n0 + u) * 256]; si[u] = SB[(size_t)(n0 + u) * 256 + 64]; }
#pragma unroll
                for (int u = 7; u >= 0; --u) { X[(size_t)(n0 + u) * XK] = (bf16)f2bf(hr); X[(size_t)(n0 + u) * XK + 64] = (bf16)f2bf(hi);
                    const float nr = ar * hr - ai * hi + sr[u]; hi = ar * hi + ai * hr + si[u]; hr = nr; }
            }
        }
    } else if (F.bx < 40) {
        const int id = (F.bx - 32) * NTHREADS + F.tid, ch = id & 1023, d = (id >> 10) & 1, b = id >> 11;
        const float* PL = (const float*)(F.ws + WS_PL) + ((size_t)(b * 2 + d) * NQ * 1024 + ch) * 2;
        float* LC = (float*)(F.ws + WS_LC) + (size_t)(b * 2 + d) * NQ * 1024 + ch;
        float h = 0.f;
        if (d == 0) {
            for (int q = 0; q < 8; ++q) { h = PL[(size_t)q * 2048] * h + PL[(size_t)q * 2048 + 1]; }
            for (int q0 = 8; q0 < NQ; q0 += 8) {
                float P[8], L[8];
#pragma unroll
                for (int u = 0; u < 8; ++u) { P[u] = PL[(size_t)(q0 + u) * 2048]; L[u] = PL[(size_t)(q0 + u) * 2048 + 1]; }
#pragma unroll
                for (int u = 0; u < 8; ++u) { LC[(size_t)(q0 + u) * 1024] = h; h = P[u] * h + L[u]; }
            }
        } else {
            for (int q = 7; q >= 0; --q) { h = PL[(size_t)q * 2048] * h + PL[(size_t)q * 2048 + 1]; }
            for (int q0 = NQ - 8; q0 >= 8; q0 -= 8) {
                float P[8], L[8];
#pragma unroll
                for (int u = 0; u < 8; ++u) { P[u] = PL[(size_t)(q0 + u) * 2048]; L[u] = PL[(size_t)(q0 + u) * 2048 + 1]; }
#pragma unroll
                for (int u = 7; u >= 0; --u) { LC[(size_t)(q0 + u) * 1024] = h; h = P[u] * h + L[u]; }
            }
        }
    }
}

constexpr unsigned char c_cand[50] = {
    0x00,0x01,0x02,0x03,0x04,0x05,0x06,0x07,0x08,0x09,0x0a,0x0b,0x0c,0x0d,0x0e,0x0f, 0x10,0x11,0x12,0x13,0x14,0x15,0x16,0x17, 0x20,
    0x21,0x22,0x23,0x24, 0x30,0x31,0x32,0x33, 0x40,0x41,0x42, 0x50,0x51, 0x60,0x61, 0x70,0x71, 0x80,0x90,0xa0,0xb0,0xc0,0xd0,0xe0,0xf0 };

__device__ __forceinline__ float umax_f(float a, float b) { return fmaxf(a, b); }

__device__ __forceinline__ float vmaxf(float a, float b) { float r; asm("v_max_f32 %0, %1, %2" : "=v"(r) : "v"(a), "v"(b)); return r; }
__device__ __forceinline__ float vminf(float a, float b) { float r; asm("v_min_f32 %0, %1, %2" : "=v"(r) : "v"(a), "v"(b)); return r; }
__device__ __forceinline__ void ce_desc(float& a, float& b) { const float hi = vmaxf(a, b), lo = vminf(a, b); a = hi; b = lo; }
constexpr unsigned char c_sort16[60] = {
    0x0d,0x1c,0x2f,0x3e,0x48,0x56,0x7b,0x9a, 0x05,0x17,0x29,0x34,0x6d,0x8e,0xaf,0xbc, 0x01,0x23,0x45,0x68,0x79,0xab,0xcd,0xef, 0x02,0x13,0x4a,0x5b,0x67,0x89,0xce,0xdf,
    0x12,0x3c,0x46,0x57,0x8a,0x9b,0xde, 0x14,0x26,0x58,0x7a,0x9d,0xbe, 0x24,0x36,0x9c,0xbd, 0x35,0x68,0x79,0xac, 0x34,0x56,0x78,0x9a,0xbc, 0x67,0x89 };
__device__ __forceinline__ void sort16_desc(float (&a)[16]) {
#pragma unroll
    for (int n = 0; n < 60; ++n) ce_desc(a[c_sort16[n] >> 4], a[c_sort16[n] & 15]);
}
__device__ __forceinline__ void merge_top16(float (&a)[16], const float (&b)[16]) {
#pragma unroll
    for (int i = 0; i < 16; ++i) a[i] = vmaxf(a[i], b[15 - i]);
#pragma unroll
    for (int j = 8; j > 0; j >>= 1)
#pragma unroll
        for (int i = 0; i < 16; ++i) { const int l = i ^ j; if (l > i) ce_desc(a[i], a[l]); }
}


__device__ __forceinline__ void peer_phase(Frame& F, const Params& p, const int parts = 7) {
    LAS int* sel_e = (LAS int*)F.lds; LAS float* sel_g = (LAS float*)(F.lds + 16640);
    LAS unsigned* tk = (LAS unsigned*)(F.lds + 33280);
    LAS unsigned char* skl = F.lds + 67072;
    const bf16* Q = (const bf16*)(F.ws + WS_Q); const bf16* SK = (const bf16*)(F.ws + WS_SKB);
    const bf16* FB = (const bf16*)(F.ws + WS_NBUF); const unsigned char* PU = F.ws + WS_PU; const unsigned char* PV = F.ws + WS_PV;
    const float* SU = (const float*)(F.ws + WS_SU); const float* SV = (const float*)(F.ws + WS_SV);
    const float* modf = (const float*)(F.ws + WS_MODF);
    const int lane = F.lane, t = lane & 31, hh = lane >> 5, head = F.wave;
    const unsigned NEG = 0xff800000u;
    __syncthreads();
    for (int i = F.tid; i < 256 * 16; i += NTHREADS) *(LAS u32x4*)(skl + (i >> 4) * 272 + (i & 15) * 16) = *(const u32x4*)(SK + (size_t)(i >> 4) * 128 + (i & 15) * 8);
    bf16x8 qf[8];
    if (F.bx < NTOK / 32) {
        const bf16* qp = Q + (size_t)(F.bx * 32 + t) * D + head * 256 + 8 * hh;
#pragma unroll
        for (int ks = 0; ks < 8; ++ks) qf[ks] = *(const bf16x8*)(qp + 16 * ks);
    }
    for (int tile = F.bx; tile < NTOK / 32; tile += F.G) {
        const int tok0 = tile * 32;
        __syncthreads();
        if (parts & 1) {
        LAS unsigned* mytk = tk + (size_t)(t * 8 + head) * 33;
#pragma unroll 1
        for (int side = 0; side < 2; ++side) {
            unsigned pk[64];
            {
                f32x16 acc[4];
#pragma unroll
                for (int kb = 0; kb < 4; ++kb) for (int i = 0; i < 16; ++i) acc[kb][i] = 0.f;
                const LAS unsigned char* sp = skl + (side * 128 + t) * 272 + 16 * hh;
#pragma unroll
                for (int ks = 0; ks < 8; ++ks) {
#pragma unroll
                    for (int kb = 0; kb < 4; ++kb) {
                        const bf16x8 sf = *(const LAS bf16x8*)(sp + kb * (32 * 272) + 32 * ks);
                        acc[kb] = __builtin_amdgcn_mfma_f32_32x32x16_bf16(sf, qf[ks], acc[kb], 0, 0, 0);
                    }
                }
                {
                    const int ntile = side ? tile + F.G : tile;
                    if (ntile < NTOK / 32) {
                        const bf16* qn = Q + (size_t)(ntile * 32 + t) * D + head * 256 + (side ^ 1) * 128 + 8 * hh;
#pragma unroll
                        for (int ks = 0; ks < 8; ++ks) qf[ks] = *(const bf16x8*)(qn + 16 * ks);
                    }
                }
#pragma unroll
                for (int kb = 0; kb < 4; ++kb)
#pragma unroll
                    for (int rg = 0; rg < 16; ++rg) pk[kb * 16 + rg] = (__float_as_uint(acc[kb][rg]) & ~0x7fu) | (unsigned)(kb * 32 + (rg & 3) + 8 * (rg >> 2) + 4 * hh);
            }
            {
                float g0[16], g1[16];
#pragma unroll
                for (int i = 0; i < 16; ++i) { g0[i] = __uint_as_float(pk[i]); g1[i] = __uint_as_float(pk[16 + i]); }
                sort16_desc(g0); sort16_desc(g1); merge_top16(g0, g1);
#pragma unroll
                for (int i = 0; i < 16; ++i) g1[i] = __uint_as_float(pk[32 + i]);
                sort16_desc(g1); merge_top16(g0, g1);
#pragma unroll
                for (int i = 0; i < 16; ++i) g1[i] = __uint_as_float(pk[48 + i]);
                sort16_desc(g1); merge_top16(g0, g1);
#pragma unroll
                for (int i = 0; i < 16; ++i) g1[i] = shx(g0[i], 32, lane);
                merge_top16(g0, g1);
                if (hh == 0) {
#pragma unroll
                    for (int i = 0; i < 16; ++i) mytk[side * 16 + i] = __float_as_uint(g0[i]);
                }
            }
        }
        LDS_WAIT(); asm volatile("" ::: "memory");
        {
            unsigned cd[25];
            {
                unsigned w0[16], w1[16];
#pragma unroll
                for (int i = 0; i < 16; ++i) { w0[i] = mytk[i]; w1[i] = mytk[16 + i]; }
#pragma unroll
                for (int n = 0; n < 25; ++n) {
                    const int idA = c_cand[n], idB = c_cand[25 + n];
                    const float vA = __uint_as_float(w0[idA >> 4] & ~0x7fu) + __uint_as_float(w1[idA & 15] & ~0x7fu);
                    const float vB = __uint_as_float(w0[idB >> 4] & ~0x7fu) + __uint_as_float(w1[idB & 15] & ~0x7fu);
                    cd[n] = hh ? ((__float_as_uint(vB) & ~0xffu) | (unsigned)idB) : ((__float_as_uint(vA) & ~0xffu) | (unsigned)idA);
                }
            }
            float c0[16], c1[16];
#pragma unroll
            for (int i = 0; i < 16; ++i) { c0[i] = __uint_as_float(cd[i]); c1[i] = (i < 9) ? __uint_as_float(cd[16 + i]) : __uint_as_float(NEG); }
            sort16_desc(c0); sort16_desc(c1); merge_top16(c0, c1);
#pragma unroll
            for (int i = 0; i < 16; ++i) c1[i] = shx(c0[i], 32, lane);
            merge_top16(c0, c1);
            float sc[16]; int ex[16];
#pragma unroll
            for (int rd = 0; rd < 16; ++rd) {
                const unsigned mb = __float_as_uint(c0[rd]);
                const unsigned w0 = mytk[(mb >> 4) & 15], w1 = mytk[16 + (mb & 15)];
                sc[rd] = __uint_as_float(w0 & ~0x7fu) + __uint_as_float(w1 & ~0x7fu);
                ex[rd] = (int)((w0 & 0x7fu) * 128u + (w1 & 0x7fu));
            }
            float mx = sc[0];
#pragma unroll
            for (int i = 1; i < 16; ++i) mx = fmaxf(mx, sc[i]);
            float sum = 0.f;
#pragma unroll
            for (int i = 0; i < 16; ++i) { sc[i] = __expf(sc[i] - mx); sum += sc[i]; }
            const float inv = 1.f / sum;
            if (hh == 0) {
#pragma unroll
                for (int i = 0; i < 16; ++i) { sel_e[t * 129 + head * 16 + i] = ex[i]; sel_g[t * 129 + head * 16 + i] = sc[i] * inv * SV[ex[i]]; }
            }
        }
        }
        __syncthreads();
        if (parts & 2) for (int i = F.tid; i < 32 * 128; i += NTHREADS) {
            const size_t gi = (size_t)tok0 * 128 + i;
            const int pp = i & 127, li = (i >> 7) * 129 + pp; ((int*)(F.ws + WS_SELE))[gi - pp + (pp & 7) * 16 + (pp >> 3)] = sel_e[li]; ((float*)(F.ws + WS_SELG))[gi] = sel_g[li]; ((float*)(F.ws + WS_SELU))[gi] = SU[sel_e[li]];
        }
    }
}

struct PeerVisit { u32x4 e[4]; u32x4 x, x2; float sc; int cs; };
template <bool VPASS>
__device__ __forceinline__ PeerVisit visit_load(const unsigned char* ws, const unsigned char* FQc, int tok, int lane) {
    PeerVisit v; const int pg = lane >> 3;
    const u32x4* ep = (const u32x4*)((const int*)(ws + WS_SELE) + (size_t)tok * 128 + pg * 16);
#pragma unroll
    for (int q = 0; q < 4; ++q) v.e[q] = ep[q];
    if (VPASS) { v.x = *(const u32x4*)(ws + WS_CFQ + (size_t)tok * 128 + pg * 16); v.x2 = v.x; v.sc = ((const float*)(ws + WS_CS))[2 * tok]; v.cs = ((const int*)(ws + WS_CS))[2 * tok + 1]; }
    else { const u32x4* fp = (const u32x4*)(FQc + (size_t)tok * D + (lane & 7) * 32); v.x = fp[0]; v.x2 = fp[1]; v.sc = 0.f; v.cs = 0; }
    return v;
}
__device__ __forceinline__ void rows16_load(u32x4 (&w)[16], const unsigned char* T, const PeerVisit& v, int lane) {
    const int pc = (lane & 7) * 16;
#pragma unroll
    for (int q = 0; q < 4; ++q) {
        w[4 * q + 0] = *(const u32x4*)(T + (v.e[q].x * 128u + (unsigned)pc)); w[4 * q + 1] = *(const u32x4*)(T + (v.e[q].y * 128u + (unsigned)pc));
        w[4 * q + 2] = *(const u32x4*)(T + (v.e[q].z * 128u + (unsigned)pc)); w[4 * q + 3] = *(const u32x4*)(T + (v.e[q].w * 128u + (unsigned)pc));
    }
}
__device__ __forceinline__ int dpp_add8(int v) {
    v += __builtin_amdgcn_update_dpp(0, v, 0xB1, 0xF, 0xF, false);
    v += __builtin_amdgcn_update_dpp(0, v, 0x4E, 0xF, 0xF, false);
    v += __builtin_amdgcn_update_dpp(0, v, 0x141, 0xF, 0xF, false);
    return v;
}
__device__ __forceinline__ void u_compute(const u32x4 (&w)[16], const PeerVisit& v, int* pd, int lane) {
    const int pg = lane >> 3, sub = lane & 7;
    int d[16];
#pragma unroll
    for (int it = 0; it < 16; ++it) {
        int tl = 0, th = 0;
        tl = __builtin_amdgcn_sdot4((int)(w[it].x & 0x0F0F0F0Fu), (int)v.x.x, tl, false);  th = __builtin_amdgcn_sdot4((int)(w[it].x & 0xF0F0F0F0u), (int)v.x.y, th, false);
        tl = __builtin_amdgcn_sdot4((int)(w[it].y & 0x0F0F0F0Fu), (int)v.x.z, tl, false);  th = __builtin_amdgcn_sdot4((int)(w[it].y & 0xF0F0F0F0u), (int)v.x.w, th, false);
        tl = __builtin_amdgcn_sdot4((int)(w[it].z & 0x0F0F0F0Fu), (int)v.x2.x, tl, false); th = __builtin_amdgcn_sdot4((int)(w[it].z & 0xF0F0F0F0u), (int)v.x2.y, th, false);
        tl = __builtin_amdgcn_sdot4((int)(w[it].w & 0x0F0F0F0Fu), (int)v.x2.z, tl, false); th = __builtin_amdgcn_sdot4((int)(w[it].w & 0xF0F0F0F0u), (int)v.x2.w, th, false);
        const int t = tl * 16 + th;
        d[it] = dpp_add8(t);
    }
    int v0 = d[0], v1 = d[8];
#pragma unroll
    for (int it = 1; it < 8; ++it) { v0 = (sub == it) ? d[it] : v0; v1 = (sub == it) ? d[8 + it] : v1; }
    pd[sub * 8 + pg] = v0; pd[64 + sub * 8 + pg] = v1;
}
typedef int i32x4v __attribute__((ext_vector_type(4)));
__device__ __forceinline__ void v_compute(const u32x4 (&w)[16], const PeerVisit& v, bf16* po, int lane) {
    i32x4v a1[4], a2[4];
#pragma unroll
    for (int q = 0; q < 4; ++q) { a1[q] = (i32x4v){0, 0, 0, 0}; a2[q] = (i32x4v){0, 0, 0, 0}; }
    const unsigned cq[4] = {v.x.x, v.x.y, v.x.z, v.x.w};
    unsigned selq[4];
#pragma unroll
    for (int sI = 0; sI < 4; ++sI) selq[sI] = 0x0C0C0C0Cu ^ ((0x0Cu ^ (unsigned)sI) << (8 * (lane & 3)));
#pragma unroll
    for (int it = 0; it < 16; ++it) {
        const int A = (int)__builtin_amdgcn_perm(0u, cq[it >> 2], selq[it & 3]);
#pragma unroll
        for (int q = 0; q < 4; ++q) {
            a1[q] = __builtin_amdgcn_mfma_i32_4x4x4i8(A, (int)w[it][q], a1[q], 0, 0, 0);
            a2[q] = __builtin_amdgcn_mfma_i32_4x4x4i8(A, (int)(w[it][q] & 0xF0F0F0F0u), a2[q], 0, 0, 0);
        }
    }
    int r1[2][4], r2[2][4];
#pragma unroll
    for (int jj = 0; jj < 2; ++jj)
#pragma unroll
        for (int i = 0; i < 4; ++i) {
            const auto t1 = __builtin_amdgcn_permlane32_swap((unsigned)a1[jj][i], (unsigned)a1[jj + 2][i], false, false); r1[jj][i] = (int)t1[0] + (int)t1[1];
            const auto t2 = __builtin_amdgcn_permlane32_swap((unsigned)a2[jj][i], (unsigned)a2[jj + 2][i], false, false); r2[jj][i] = (int)t2[0] + (int)t2[1];
        }
    int s1[4], s2[4];
#pragma unroll
    for (int i = 0; i < 4; ++i) {
        const auto t1 = __builtin_amdgcn_permlane16_swap((unsigned)r1[0][i], (unsigned)r1[1][i], false, false); s1[i] = (int)t1[0] + (int)t1[1];
        const auto t2 = __builtin_amdgcn_permlane16_swap((unsigned)r2[0][i], (unsigned)r2[1][i], false, false); s2[i] = (int)t2[0] + (int)t2[1];
        s1[i] += __builtin_amdgcn_update_dpp(0, s1[i], 0x128, 0xF, 0xF, false);
        s2[i] += __builtin_amdgcn_update_dpp(0, s2[i], 0x128, 0xF, 0xF, false);
    }
    if (!(lane & 8)) {
        const float csf = (float)v.cs; float lo[4], hi[4];
#pragma unroll
        for (int i = 0; i < 4; ++i) { lo[i] = ((float)(s1[i] - s2[i]) - 7.5f * csf) * v.sc; hi[i] = ((float)s2[i] * 0.0625f + 0.5f * csf) * v.sc; }
        u32x4 o;
        o.x = cvt_pk_bf16(lo[0], lo[1]); o.y = cvt_pk_bf16(lo[2], lo[3]); o.z = cvt_pk_bf16(hi[0], hi[1]); o.w = cvt_pk_bf16(hi[2], hi[3]);
        *(u32x4*)(po + (lane & 7) * 32 + 8 * (((lane >> 4) & 1) + 2 * (lane >> 5))) = o;
    }
}
template <bool VPASS>
__device__ __forceinline__ void peer_pass(Frame& F, int c, int rank, int nblk) {
    const unsigned char* T = F.ws + (VPASS ? WS_PV : WS_PU) + (size_t)c * 16384 * 128; const unsigned char* FQc = F.ws + WS_FQ + c * 256;
    int* PD = (int*)(F.ws + WS_PD) + (size_t)c * NTOK * 128; bf16* PO = (bf16*)(F.ws + WS_PO) + c * 256;
    const int t0 = rank * NWAVES + F.wave, step = nblk * NWAVES;
    if (t0 >= NTOK) return;
    const int nvis = (NTOK - t0 + step - 1) / step;
    int lane = F.lane; asm volatile("" : "+v"(lane));
    PeerVisit va = visit_load<VPASS>(F.ws, FQc, t0, lane), vb = va;
    u32x4 wa[16], wb[16];
    rows16_load(wa, T, va, lane);
    if (nvis > 1) vb = visit_load<VPASS>(F.ws, FQc, t0 + step, lane);
#pragma unroll 1
    for (int v = 0; v < nvis; v += 2) {
        const int tok = t0 + v * step;
        asm volatile("" : "+v"(lane));
        PeerVisit vn = va;
        if (v + 1 < nvis) rows16_load(wb, T, vb, lane);
        if (v + 2 < nvis) vn = visit_load<VPASS>(F.ws, FQc, tok + 2 * step, lane);
        if (VPASS) v_compute(wa, va, PO + (size_t)tok * D, lane); else u_compute(wa, va, PD + (size_t)tok * 128, lane);
        if (v + 1 < nvis) {
            PeerVisit vm = vb;
            if (v + 2 < nvis) rows16_load(wa, T, vn, lane);
            if (v + 3 < nvis) vm = visit_load<VPASS>(F.ws, FQc, tok + 3 * step, lane);
            if (VPASS) v_compute(wb, vb, PO + (size_t)(tok + step) * D, lane); else u_compute(wb, vb, PD + (size_t)(tok + step) * 128, lane);
            vb = vm;
        }
        va = vn;
    }
}
struct CfIn { int d0[8], d1[8]; float fs; int s0, s1; float u0, u1, g0, g1; };
__device__ __forceinline__ void cf_load(CfIn& r, const unsigned char* ws, int tok, int lane) {
#pragma unroll
    for (int c = 0; c < 8; ++c) { const int* pd = (const int*)(ws + WS_PD) + ((size_t)c * NTOK + tok) * 128; r.d0[c] = pd[lane]; r.d1[c] = pd[64 + lane]; }
    r.fs = ((const float*)(ws + WS_FS))[tok]; r.s0 = ((const int*)(ws + WS_FS + (1u << 20)))[2 * tok]; r.s1 = ((const int*)(ws + WS_FS + (1u << 20)))[2 * tok + 1];
    r.u0 = ((const float*)(ws + WS_SELU))[(size_t)tok * 128 + lane]; r.u1 = ((const float*)(ws + WS_SELU))[(size_t)tok * 128 + 64 + lane];
    r.g0 = ((const float*)(ws + WS_SELG))[(size_t)tok * 128 + lane]; r.g1 = ((const float*)(ws + WS_SELG))[(size_t)tok * 128 + 64 + lane];
}
__device__ __forceinline__ void peer_cf(Frame& F) {
    const int lane = F.lane, gw = F.bx * NWAVES + F.wave, NGW = F.G * NWAVES;
    CfIn rn;
    if (gw < NTOK) cf_load(rn, F.ws, gw, lane);
    for (int tok = gw; tok < NTOK; tok += NGW) {
        const CfIn r = rn;
        if (tok + NGW < NTOK) cf_load(rn, F.ws, tok + NGW, lane);
        int d0 = 0, d1 = 0;
#pragma unroll
        for (int c = 0; c < 8; ++c) { d0 += r.d0[c]; d1 += r.d1[c]; }
        const float foff = 7.5f * (float)r.s0 - 0.5f * (float)r.s1;
        const float c0 = r.g0 * gelu_f(((float)d0 * 0.0625f - foff) * (r.u0 * r.fs)), c1 = r.g1 * gelu_f(((float)d1 * 0.0625f - foff) * (r.u1 * r.fs));
        float am = fmaxf(fabsf(c0), fabsf(c1));
#pragma unroll
        for (int o = 1; o < 64; o <<= 1) am = fmaxf(am, shx(am, o, lane));
        const float inv = am > 0.f ? 127.f / am : 0.f;
        const int q0 = (int)rintf(c0 * inv), q1 = (int)rintf(c1 * inv);
        unsigned char* cq = F.ws + WS_CFQ + (size_t)tok * 128;
        cq[(lane & 7) * 16 + (lane >> 3)] = (unsigned char)(q0 & 255); cq[(lane & 7) * 16 + 8 + (lane >> 3)] = (unsigned char)(q1 & 255);
        int qs = q0 + q1;
#pragma unroll
        for (int o = 1; o < 64; o <<= 1) qs += shx(qs, o, lane);
        if (lane == 0) { ((float*)(F.ws + WS_CS))[2 * tok] = am * (1.f / 127.f); ((int*)(F.ws + WS_CS))[2 * tok + 1] = qs; }
    }
}
struct FinalRow { u32x2 m[8], q[8]; };
__device__ __forceinline__ void final_row_load(FinalRow& r, const Params& p, const unsigned char* ws, int tok, int lane) {
    const bf16* mrow = (const bf16*)(ws + WS_MIX) + (size_t)tok * D; const bf16* prow = (const bf16*)(ws + WS_PO) + (size_t)tok * D;
#pragma unroll
    for (int j = 0; j < 8; ++j) { const int el = 4 * lane + 256 * j; r.m[j] = *(const u32x2*)(mrow + el); r.q[j] = *(const u32x2*)(prow + el); }
}
__device__ __forceinline__ void peer_final(Frame& F, const Params& p) {
    const float* modf = (const float*)(F.ws + WS_MODF);
    const int lane = F.lane, gw = F.bx * NWAVES + F.wave, NGW = F.G * NWAVES;
    FinalRow rn;
    if (gw < NTOK) final_row_load(rn, p, F.ws, gw, lane);
    for (int tok = gw; tok < NTOK; tok += NGW) {
        FinalRow r = rn;
        if (tok + NGW < NTOK) final_row_load(rn, p, F.ws, tok + NGW, lane);
        float* hrow = p.out + (size_t)tok * D;
        const float* m5 = modf + (size_t)(tok >> 14) * 12288 + 5 * D; float ss = 0.f;
        f32x4 v[8];
#pragma unroll
        for (int j = 0; j < 8; ++j) {
            const int el = 4 * lane + 256 * j; const f32x4 g4 = *(const f32x4*)(m5 + el);
            const float mf[4] = {bf_lo(r.m[j].x), bf_hi(r.m[j].x), bf_lo(r.m[j].y), bf_hi(r.m[j].y)}, pf[4] = {bf_lo(r.q[j].x), bf_hi(r.q[j].x), bf_lo(r.q[j].y), bf_hi(r.q[j].y)};
#pragma unroll
            for (int i = 0; i < 4; ++i) { const float t = mf[i] + g4[i] * pf[i]; v[j][i] = t; ss += t * t; }
        }
        const float rstd = rsqrtf(wave_sum(ss, lane) * (1.f / D) + 1e-6f);
#pragma unroll
        for (int j = 0; j < 8; ++j) {
            const int el = 4 * lane + 256 * j; const f32x4 gf = *(const f32x4*)(p.in[32] + el);
            *(f32x4*)(hrow + el) = (f32x4){v[j][0] * rstd * gf[0], v[j][1] * rstd * gf[1], v[j][2] * rstd * gf[2], v[j][3] * rstd * gf[3]};
        }
    }
}

#ifndef DUPMASK
#define DUPMASK 0
#endif
#define REFRESH() do { F.lane = lane_id(); F.tid = F.wave * 64 + F.lane; } while (0)
#define RUNPH(n, ...) do { REFRESH(); { __VA_ARGS__ } if ((DUPMASK >> (n)) & 1) { grid.sync(); REFRESH(); { __VA_ARGS__ } } } while (0)
__global__ void __launch_bounds__(NTHREADS, 2) fwd_megakernel(Params p) {
    extern __shared__ __attribute__((aligned(16))) unsigned char lds_raw[];
    cg::grid_group grid = cg::this_grid();
    Frame F; F.lds = (LAS unsigned char*)lds_raw; F.tid = threadIdx.x; F.lane = F.tid & 63; F.wave = __builtin_amdgcn_readfirstlane(F.tid >> 6); F.G = gridDim.x; F.bx = blockIdx.x; F.ws = p.ws;
    volatile LAS unsigned* bst = (volatile LAS unsigned*)(F.lds + LDS_BYTES - 16);
    if (F.tid < 4) bst[F.tid] = 0u;
    __syncthreads();
    const XcdBarrier xbar = xcd_barrier_post((unsigned*)(p.ws), bst, F.tid == 0);
    if (F.tid == 0) { bst[2] = xb_add((unsigned*)p.ws + CW_RANK + 64 * xbar.x, 1u); bst[3] = xb_add((unsigned*)p.ws + CW_TICKET, 1u); }
#define GSYNC() xcd_barrier(xbar, (F.wave == 0) && (lane_id() == 0))

    RUNPH(0, phase0a(F, p););
    if (DUPMASK & 0x700000) { grid.sync(); REFRESH(); phase0a(F, p, (DUPMASK >> 20) & 7); }
    if (p.out == nullptr) grid.sync();
    GSYNC();
    RUNPH(1, phase_norm(F, p, 0););
    GSYNC();
    RUNPH(2, ctx_in_gemm(F);
        REFRESH();
        pg8::Sched S; S.A = (const char*)(F.ws + WS_NBUF8); S.B = (const char*)(F.ws + WS_WINI8); S.gA = 0; S.gB = 0; S.lda = D; S.ldb = D; S.nM = NTOK / 256; S.nN = INW / 256; S.nG = 1; S.G = F.G; S.c = F.bx;
        S.A2 = S.A; S.B2 = S.B; S.pair = 0; S.esz = 1;
        pg8::Epi E; E.mode = pg8::EM_IN; E.ws = F.ws; E.x = p.in[0]; E.out = p.out; E.modf = (const float*)(F.ws + WS_MODF);
        pg8::gemm_phase<true>(F.lds, D, S, E, F.wave););
    if (DUPMASK & 0x8000) { GSYNC(); REFRESH(); big_gemm(F, p, pg8::EM_PROBE, F.ws + WS_NBUF, D, F.ws + WS_WIN, D, NTOK, D, D); }
    GSYNC();
    RUNPH(3,
        pg8::Sched S; S.A = (const char*)(F.ws + WS_X); S.B = (const char*)(F.ws + WS_MS); S.gA = (size_t)NCHUNK * XK * 2; S.gB = (size_t)256 * 512 * 2; S.lda = XK; S.ldb = 512; S.nM = 4; S.nN = 1; S.nG = 64; S.G = F.G; S.c = F.bx; S.A2 = S.A; S.B2 = S.B; S.pair = 0; S.esz = 2;
        pg8::Epi E; E.mode = pg8::EM_S5S; E.ws = F.ws; E.x = p.in[0]; E.out = p.out; E.modf = (const float*)(F.ws + WS_MODF);
        pg8::gemm_phase(F.lds, 512, S, E, F.wave);
        REFRESH(); ctx_s5_states(F);
        lru_phase<1>(F, p); if (DUPMASK & 0x1000) { GSYNC(); REFRESH(); lru_phase<1>(F, p); });
    GSYNC();
    RUNPH(4, phase_carry(F, p););
    GSYNC();
    RUNPH(5,
        pg8::Sched S; S.A = (const char*)(F.ws + WS_X); S.B = (const char*)(F.ws + WS_MFULL); S.gA = (size_t)NCHUNK * XK * 2; S.gB = (size_t)512 * XK * 2; S.lda = XK; S.ldb = XK; S.nM = 4; S.nN = 2; S.nG = 64; S.G = F.G; S.c = F.bx; S.A2 = S.A; S.B2 = S.B; S.pair = 0; S.esz = 2;
        pg8::Epi E; E.mode = pg8::EM_S5Y; E.ws = F.ws; E.x = p.in[0]; E.out = p.out; E.modf = (const float*)(F.ws + WS_MODF);
        pg8::gemm_phase(F.lds, XK, S, E, F.wave);
        REFRESH(); lru_phase<2>(F, p); if (DUPMASK & 0x2000) { GSYNC(); REFRESH(); lru_phase<2>(F, p); });
    GSYNC();
    RUNPH(6, big_gemm(F, p, pg8::EM_GLU, F.ws + WS_ZA, S5W, F.ws + WS_WGLU, S5W, NTOK, S5W, S5W););
    GSYNC();
    RUNPH(7,
        pg8::Sched S; S.A = (const char*)(F.ws + WS_YA); S.B = (const char*)(F.ws + WS_WPA); S.A2 = (const char*)(F.ws + WS_YB); S.B2 = (const char*)(F.ws + WS_WPB); S.pair = 1; S.esz = 2;
        S.gA = 0; S.gB = 0; S.lda = S5W; S.ldb = S5W; S.nM = NTOK / 256; S.nN = D / 256; S.nG = 1; S.G = F.G; S.c = F.bx;
        pg8::Epi E; E.mode = pg8::EM_PAB; E.ws = F.ws; E.x = p.in[0]; E.out = p.out; E.modf = (const float*)(F.ws + WS_MODF);
        pg8::gemm_phase(F.lds, S5W, S, E, F.wave););
    GSYNC();
    RUNPH(8, big_gemm(F, p, pg8::EM_OUT, F.ws + WS_NBUF, D, F.ws + WS_WOUT, D, NTOK, D, D););
    GSYNC();
    RUNPH(9, phase_norm(F, p, 1););
    GSYNC();
    RUNPH(10, big_gemm(F, p, pg8::EM_Q, F.ws + WS_NBUF, D, F.ws + WS_WQ, D, NTOK, D, D););
    GSYNC();
    if (DUPMASK & 0x4000) { for (int i = 0; i < 10; ++i) GSYNC(); }
    REFRESH(); peer_phase(F, p);
    if (DUPMASK & 0x8000) { GSYNC(); REFRESH(); peer_phase(F, p, (DUPMASK >> 24) & 7); }
    GSYNC();
    {
        int sp, rank, nblk;
        {
            unsigned* bar = (unsigned*)p.ws; bool ok = true; unsigned mine = 0;
            for (unsigned j = 0; j < 16; ++j) { const unsigned cnt = xb_ld(&bar[XB_XCNT(j)]); if ((j < 8) != (cnt > 0u)) ok = false; if (j == xbar.x) mine = cnt; }
            const unsigned tk = bst[3];
            if (ok) { sp = (int)xbar.x; rank = (int)bst[2]; nblk = (int)mine; }
            else { sp = (int)(tk & 7u); rank = (int)(tk >> 3); nblk = (int)((F.G + 7 - (tk & 7u)) / 8); }
            sp = __builtin_amdgcn_readfirstlane(sp); rank = __builtin_amdgcn_readfirstlane(rank); nblk = __builtin_amdgcn_readfirstlane(nblk);
        }
        REFRESH(); peer_pass<false>(F, sp, rank, nblk);
        if (DUPMASK & 0x10000) { GSYNC(); REFRESH(); peer_pass<false>(F, sp, rank, nblk); }
        GSYNC();
        REFRESH(); peer_cf(F);
        if (DUPMASK & 0x20000) { GSYNC(); REFRESH(); peer_cf(F); }
        GSYNC();
        REFRESH(); peer_pass<true>(F, sp, rank, nblk);
        if (DUPMASK & 0x40000) { GSYNC(); REFRESH(); peer_pass<true>(F, sp, rank, nblk); }
        GSYNC();
        REFRESH(); peer_final(F, p);
        if (DUPMASK & 0x80000) { GSYNC(); REFRESH(); peer_final(F, p); }
    }
}

extern "C" void kernel_launch(void* const* d_in, const int* in_sizes, int n_in, void* d_out, int out_size, void* d_ws, size_t ws_size, hipStream_t stream) {
    static int grid_blocks = 0;
    if (!grid_blocks) {
        int dev = 0, cus = 0, per_cu = 0;
        (void)hipGetDevice(&dev);
        (void)hipDeviceGetAttribute(&cus, hipDeviceAttributeMultiprocessorCount, dev);
        (void)hipFuncSetAttribute((const void*)fwd_megakernel, hipFuncAttributeMaxDynamicSharedMemorySize, LDS_BYTES);
        (void)hipOccupancyMaxActiveBlocksPerMultiprocessor(&per_cu, (const void*)fwd_megakernel, NTHREADS, LDS_BYTES);
        if (per_cu < 1) per_cu = 1;
        grid_blocks = cus;
        if (ws_size < WS_END) { fprintf(stderr, "kernel_launch: workspace too small (%zu < %zu)\n", ws_size, (size_t)WS_END); grid_blocks = -1; }
    }
    if (grid_blocks < 0) return;
    (void)hipMemsetAsync(d_ws, 0, 65536, stream);
    Params p{};
    for (int i = 0; i < 33; ++i) p.in[i] = (const float*)d_in[i];
    p.out = (float*)d_out; p.ws = (unsigned char*)d_ws;
    void* args[] = {&p};
    hipError_t e = hipLaunchCooperativeKernel((const void*)fwd_megakernel, dim3(grid_blocks), dim3(NTHREADS), args, LDS_BYTES, stream);
    if (e != hipSuccess) fprintf(stderr, "cooperative launch failed: %s (grid %d)\n", hipGetErrorString(e), grid_blocks);
}
```
